# Optimizing an MI355X kernel written in HIP

```python
import math
import jax, jax.numpy as jnp
from jax import lax
import numpy as np

D_MODEL = 2048
BATCH = 2
SEQ = 4096
DEPTH = 2

HEAD_DIM = 128
ROPE_DIM = HEAD_DIM // 4
ROPE_THETA = 500000.0

MOBA_HEADS = 8
MOBA_BLOCK = 256
MOBA_TOPK = 3
MOBA_Q_CHUNK = 32
MOBA_WIDTH = MOBA_HEADS * HEAD_DIM

DIFF_HEADS = 4
DIFF_V_DIM = 2 * HEAD_DIM
DIFF_Q_BLOCK = 128
DIFF_QK_WIDTH = DIFF_HEADS * 2 * HEAD_DIM
DIFF_V_WIDTH = DIFF_HEADS * DIFF_V_DIM

IN_COLS = 3 * MOBA_WIDTH + 2 * DIFF_QK_WIDTH + DIFF_V_WIDTH + 2 * D_MODEL

PEER_HEADS = 8
PEER_N_KEYS = 128
PEER_N_EXPERTS = PEER_N_KEYS * PEER_N_KEYS
PEER_HALF = 128
PEER_KEY_DIM = 2 * PEER_HALF
PEER_TOPK = 16
PEER_TOKEN_CHUNK = 128

LN_EPS = 1e-5
RMS_EPS = 1e-5
NEG = -1e30
DEEPNORM_ALPHA = (2 * DEPTH) ** 0.25
DEEPNORM_BETA = (8 * DEPTH) ** -0.25

kernel_name = "hybrid_moba_diffattn_peer_deepnorm"


def layer_norm(x, g, b):
    xf = x.astype(jnp.float32)
    mu = jnp.mean(xf, -1, keepdims=True)
    var = jnp.mean(jnp.square(xf - mu), -1, keepdims=True)
    return ((xf - mu) * lax.rsqrt(var + LN_EPS) * g + b).astype(x.dtype)


def partial_rope(x, pos):
    half = ROPE_DIM // 2
    inv_freq = 1.0 / (ROPE_THETA ** (jnp.arange(half, dtype=jnp.float32) / half))
    ang = pos.astype(jnp.float32)[:, None] * inv_freq[None, :]
    cos = jnp.cos(ang).astype(x.dtype)
    sin = jnp.sin(ang).astype(x.dtype)
    x1, x2, rest = x[..., :half], x[..., half:ROPE_DIM], x[..., ROPE_DIM:]
    return jnp.concatenate([x1 * cos - x2 * sin, x1 * sin + x2 * cos, rest], -1)


def moba_attention(q, k, v):
    B, H, S, hd = q.shape
    nb = -(-S // MOBA_BLOCK)
    s_pad = nb * MOBA_BLOCK
    pad = ((0, 0), (0, 0), (0, s_pad - S), (0, 0))
    kb = jnp.pad(k, pad).reshape(B, H, nb, MOBA_BLOCK, hd)
    vb = jnp.pad(v, pad).reshape(B, H, nb, MOBA_BLOCK, hd)
    k_mean = jnp.mean(kb.astype(jnp.float32), axis=3)
    n_sel = max(1, min(MOBA_TOPK, nb - 1))
    n_chunks = S // MOBA_Q_CHUNK
    qc = q.reshape(B, H, n_chunks, MOBA_Q_CHUNK, hd).transpose(2, 0, 1, 3, 4)
    scale = hd ** -0.5
    b_idx = jnp.arange(B)[:, None, None, None]
    h_idx = jnp.arange(H)[None, :, None, None]
    blk_ids = jnp.arange(nb)

    def chunk_fn(args):
        c, q_c = args
        q_pos = c * MOBA_Q_CHUNK + jnp.arange(MOBA_Q_CHUNK)
        own = (c * MOBA_Q_CHUNK) // MOBA_BLOCK
        gate = jnp.einsum('bhqd,bhnd->bhqn', q_c.astype(jnp.float32), k_mean)
        gate = jnp.where(blk_ids < own, gate, NEG)
        _, sel = lax.top_k(gate, n_sel)
        sel_valid = sel < own
        k_sel = kb[b_idx, h_idx, sel]
        v_sel = vb[b_idx, h_idx, sel]
        s_sel = jnp.einsum('bhqd,bhqnkd->bhqnk', q_c, k_sel).astype(jnp.float32) * scale
        s_sel = jnp.where(sel_valid[..., None], s_sel, NEG)
        k_own = lax.dynamic_index_in_dim(kb, own, axis=2, keepdims=False)
        v_own = lax.dynamic_index_in_dim(vb, own, axis=2, keepdims=False)
        s_own = jnp.einsum('bhqd,bhkd->bhqk', q_c, k_own).astype(jnp.float32) * scale
        k_pos = own * MOBA_BLOCK + jnp.arange(MOBA_BLOCK)
        s_own = jnp.where(k_pos[None, :] <= q_pos[:, None], s_own, NEG)
        s_all = jnp.concatenate([s_sel.reshape(B, H, MOBA_Q_CHUNK, n_sel * MOBA_BLOCK), s_own], -1)
        p = jax.nn.softmax(s_all, axis=-1).astype(v.dtype)
        p_sel = p[..., :n_sel * MOBA_BLOCK].reshape(B, H, MOBA_Q_CHUNK, n_sel, MOBA_BLOCK)
        p_own = p[..., n_sel * MOBA_BLOCK:]
        return (jnp.einsum('bhqnk,bhqnkd->bhqd', p_sel, v_sel)
                + jnp.einsum('bhqk,bhkd->bhqd', p_own, v_own))

    out = lax.map(chunk_fn, (jnp.arange(n_chunks), qc))
    return out.transpose(1, 2, 0, 3, 4).reshape(B, H, S, hd)


def diff_attention(q, k, v, lam, subln_g, lambda_init):
    B, H, _, S, hd = q.shape
    n_blocks = S // DIFF_Q_BLOCK
    qb = q.reshape(B, H, 2, n_blocks, DIFF_Q_BLOCK, hd).transpose(3, 0, 1, 2, 4, 5)
    k_pos = jnp.arange(S)
    scale = hd ** -0.5

    def block_fn(args):
        i, q_i = args
        q_pos = i * DIFF_Q_BLOCK + jnp.arange(DIFF_Q_BLOCK)
        s = jnp.einsum('bhcqd,bhckd->bhcqk', q_i, k).astype(jnp.float32) * scale
        s = jnp.where(k_pos[None, :] <= q_pos[:, None], s, NEG)
        p = jax.nn.softmax(s, axis=-1)
        w = p[:, :, 0] - lam * p[:, :, 1]
        return jnp.einsum('bhqk,bhkd->bhqd', w.astype(v.dtype), v)

    o = lax.map(block_fn, (jnp.arange(n_blocks), qb))
    o = o.transpose(1, 2, 0, 3, 4).reshape(B, H, S, DIFF_V_DIM).astype(jnp.float32)
    o = o * lax.rsqrt(jnp.mean(jnp.square(o), -1, keepdims=True) + RMS_EPS) * subln_g
    return (o * (1.0 - lambda_init)).astype(v.dtype)


def hybrid_mixer(x, w_in, w_br_moba, w_br_diff, w_out, diff_lambda, diff_subln_g, layer_idx):
    B, S, _ = x.shape
    pos = jnp.arange(S)
    h = x @ w_in
    widths = [MOBA_WIDTH, MOBA_WIDTH, MOBA_WIDTH, DIFF_QK_WIDTH, DIFF_QK_WIDTH, DIFF_V_WIDTH, D_MODEL]
    cuts = list(np.cumsum(widths))
    q_m, k_m, v_m, q_d, k_d, v_d, g_m, g_d = jnp.split(h, [int(c) for c in cuts], axis=-1)

    def mheads(t):
        return t.reshape(B, S, MOBA_HEADS, HEAD_DIM).transpose(0, 2, 1, 3)
    y_m = moba_attention(partial_rope(mheads(q_m), pos), partial_rope(mheads(k_m), pos), mheads(v_m))
    y_m = y_m.transpose(0, 2, 1, 3).reshape(B, S, MOBA_WIDTH)

    def dheads(t):
        return t.reshape(B, S, DIFF_HEADS, 2, HEAD_DIM).transpose(0, 2, 3, 1, 4)
    lamf = diff_lambda.astype(jnp.float32)
    lambda_init = 0.8 - 0.6 * math.exp(-0.3 * layer_idx)
    lam = jnp.exp(jnp.sum(lamf[0] * lamf[1])) - jnp.exp(jnp.sum(lamf[2] * lamf[3])) + lambda_init
    v_dh = v_d.reshape(B, S, DIFF_HEADS, DIFF_V_DIM).transpose(0, 2, 1, 3)
    y_d = diff_attention(partial_rope(dheads(q_d), pos), partial_rope(dheads(k_d), pos), v_dh,
                         lam, diff_subln_g, lambda_init)
    y_d = y_d.transpose(0, 2, 1, 3).reshape(B, S, DIFF_V_WIDTH)

    merged = jax.nn.sigmoid(g_m) * (y_m @ w_br_moba) + jax.nn.sigmoid(g_d) * (y_d @ w_br_diff)
    return merged @ w_out


def peer_ffn(x, w_q, sub_keys, u, v):
    B, S, D = x.shape
    T = B * S
    xt = x.reshape(T, D)
    q = (xt @ w_q).reshape(T, PEER_HEADS, 2, PEER_HALF)
    s = jnp.einsum('thcd,hcnd->thcn', q, sub_keys).astype(jnp.float32)
    s_top, i_top = lax.top_k(s, PEER_TOPK)
    cand_s = s_top[:, :, 0, :, None] + s_top[:, :, 1, None, :]
    cand_i = i_top[:, :, 0, :, None] * PEER_N_KEYS + i_top[:, :, 1, None, :]
    best_s, best_pos = lax.top_k(cand_s.reshape(T, PEER_HEADS, PEER_TOPK * PEER_TOPK), PEER_TOPK)
    expert_idx = jnp.take_along_axis(cand_i.reshape(T, PEER_HEADS, PEER_TOPK * PEER_TOPK), best_pos, -1)
    gates = jax.nn.softmax(best_s, axis=-1).astype(x.dtype)
    n_chunks = T // PEER_TOKEN_CHUNK
    hk = PEER_HEADS * PEER_TOPK

    def chunk_fn(args):
        x_c, idx_c, g_c = args
        u_c = u[idx_c]
        v_c = v[idx_c]
        act = jax.nn.gelu(jnp.einsum('cd,ced->ce', x_c, u_c), approximate=False)
        return jnp.einsum('ce,ced->cd', g_c * act, v_c)

    out = lax.map(chunk_fn, (xt.reshape(n_chunks, PEER_TOKEN_CHUNK, D),
                             expert_idx.reshape(n_chunks, PEER_TOKEN_CHUNK, hk),
                             gates.reshape(n_chunks, PEER_TOKEN_CHUNK, hk)))
    return out.reshape(B, S, D)


def setup_inputs(seed: int = 0) -> dict:
    key = jax.random.key(seed)
    ks = jax.random.split(key, 16)
    f32 = jnp.float32

    def nrm(k, shape, scale):
        return jax.random.normal(k, shape, f32) * scale

    return {
        "x": nrm(ks[0], (BATCH, SEQ, D_MODEL), 1.0),
        "w_in": nrm(ks[1], (DEPTH, D_MODEL, IN_COLS), D_MODEL ** -0.5),
        "w_br_moba": nrm(ks[2], (DEPTH, MOBA_WIDTH, D_MODEL), DEEPNORM_BETA * MOBA_WIDTH ** -0.5),
        "w_br_diff": nrm(ks[3], (DEPTH, DIFF_V_WIDTH, D_MODEL), DEEPNORM_BETA * DIFF_V_WIDTH ** -0.5),
        "w_out": nrm(ks[4], (DEPTH, D_MODEL, D_MODEL), DEEPNORM_BETA * D_MODEL ** -0.5),
        "diff_lambda": nrm(ks[5], (DEPTH, 4, HEAD_DIM), 0.1),
        "diff_subln_g": 1.0 + nrm(ks[6], (DEPTH, DIFF_V_DIM), 0.02),
        "ln1_g": 1.0 + nrm(ks[7], (DEPTH, D_MODEL), 0.02),
        "ln1_b": nrm(ks[8], (DEPTH, D_MODEL), 0.02),
        "peer_w_q": nrm(ks[9], (DEPTH, D_MODEL, PEER_HEADS * PEER_KEY_DIM), D_MODEL ** -0.5),
        "peer_sub_keys": nrm(ks[10], (DEPTH, PEER_HEADS, 2, PEER_N_KEYS, PEER_HALF), PEER_HALF ** -0.5),
        "peer_u": nrm(ks[11], (DEPTH, PEER_N_EXPERTS, D_MODEL), D_MODEL ** -0.5),
        "peer_v": nrm(ks[12], (DEPTH, PEER_N_EXPERTS, D_MODEL), DEEPNORM_BETA),
        "ln2_g": 1.0 + nrm(ks[13], (DEPTH, D_MODEL), 0.02),
        "ln2_b": nrm(ks[14], (DEPTH, D_MODEL), 0.02),
    }


def reference(x, w_in, w_br_moba, w_br_diff, w_out, diff_lambda, diff_subln_g, ln1_g, ln1_b,
              peer_w_q, peer_sub_keys, peer_u, peer_v, ln2_g, ln2_b):
    for l in range(DEPTH):
        mix = hybrid_mixer(x, w_in[l], w_br_moba[l], w_br_diff[l], w_out[l],
                           diff_lambda[l], diff_subln_g[l], l)
        x = layer_norm(DEEPNORM_ALPHA * x + mix, ln1_g[l], ln1_b[l])
        ffn = peer_ffn(x, peer_w_q[l], peer_sub_keys[l], peer_u[l], peer_v[l])
        x = layer_norm(DEEPNORM_ALPHA * x + ffn, ln2_g[l], ln2_b[l])
    return x
```

```cpp
#include <hip/hip_runtime.h>
#include <cstdio>
#include <cstdint>
#define MK_ONE_LAUNCH 0
__device__ __forceinline__ int opq_tid() { int t = threadIdx.x; asm volatile("" : "+v"(t)); return t; }
namespace pg8 {
#define PG8_LAS __attribute__((address_space(3)))
typedef unsigned short bf16_t;
typedef short bf16x8 __attribute__((ext_vector_type(8)));
typedef float f32x4 __attribute__((ext_vector_type(4)));
typedef unsigned u32x4 __attribute__((ext_vector_type(4)));
constexpr int BM = 256, BK = 64, HALF = 128, HTB = HALF * BK * 2  , STAGE_BYTES = 8 * HTB, NXCD = 8, WGM = 8;

__host__ __device__ __forceinline__ int lds_byte(int r, int c) { const int st = (r >> 4) * 2 + (c >> 5), rr = r & 15, cc = c & 31, ob = rr * 64 + cc * 2; return st * 1024 + (ob ^ (((ob >> 9) & 1) << 5)); }
__host__ __device__ __forceinline__ void stage_rc(int b, int& R, int& C) { const int st = b / 1024, sb = b % 1024, swz = sb ^ (((sb >> 9) & 1) << 5); R = (st >> 1) * 16 + swz / 64; C = (st & 1) * 32 + (swz % 64) / 2; }
__host__ __device__ __forceinline__ int perm32(int rho) { const int n = rho >> 4, i = rho & 15; return 8 * (i >> 2) + 4 * n + (i & 3); }

struct Unit { int pm, pn; };
struct Gemm { const bf16_t* A; const bf16_t* Bt; int M, N, K; };

struct StaticOrder {
    int nM, nN, nwg, G, c;
    __host__ __device__ void init(int M, int N, int G_, int c_) { nM = M / BM; nN = N / BM; nwg = nM * nN; G = G_; c = c_; }
    __host__ __device__ bool next(int i, Unit& u) const {
        const long L = (long)i * G + c; if (L >= nwg) return false;
        int wgid = (int)L; { const int q = nwg / NXCD, r = nwg % NXCD, xcd = wgid % NXCD, off = wgid / NXCD; wgid = (xcd < r ? xcd * (q + 1) : r * (q + 1) + (xcd - r) * q) + off; }
        const int nig = WGM * nN, gid = wgid / nig, fm = gid * WGM, gsz = (nM - fm) < WGM ? (nM - fm) : WGM;
        u.pm = fm + ((wgid % nig) % gsz); u.pn = (wgid % nig) / gsz; return true;
    }
    __device__ __forceinline__ void a_ready(const Unit&) const {}
    __device__ __forceinline__ void done(const Unit&) const {}
};
__device__ __forceinline__ unsigned cvt_pk_bf16(float lo, float hi) { unsigned r; asm volatile("v_cvt_pk_bf16_f32 %0, %1, %2" : "=v"(r) : "v"(lo), "v"(hi)); return r; }
__device__ __forceinline__ void st_bf16x4(bf16_t* p, f32x4 v) {
    const unsigned long long w = (unsigned long long)cvt_pk_bf16(v[0], v[1]) | ((unsigned long long)cvt_pk_bf16(v[2], v[3]) << 32);
    *(unsigned long long*)p = w;
}
__device__ __forceinline__ f32x4 ld_bf16x4(const bf16_t* p) {
    const unsigned long long w = *(const unsigned long long*)p; const unsigned lo = (unsigned)w, hi = (unsigned)(w >> 32);
    return (f32x4){__uint_as_float(lo << 16), __uint_as_float(lo & 0xffff0000u), __uint_as_float(hi << 16), __uint_as_float(hi & 0xffff0000u)};
}
struct EpiIn {
    static constexpr bool PERM = false, AFTER_DRAIN = false;
    bf16_t* qkv; bf16_t* gates; const float* cosT; const float* sinT;
    __device__ __forceinline__ void operator()(const f32x4 (&acc)[2][2][4][2], const Unit& u, int wr, int wc, int fr, int fq) const {
        const int pn = u.pn;
        if (pn < 24) {
            const int reg = pn >> 2;
            const bool rope = (reg == 0 || reg == 1 || reg == 3 || reg == 4) && (wc == 0);
#pragma unroll
            for (int ai = 0; ai < 2; ++ai)
#pragma unroll
                for (int m = 0; m < 4; ++m) {
                    const int row = u.pm * BM + ai * HALF + wr * 64 + m * 16 + fr, b = row >> 12, s = row & 4095;
                    f32x4 cs = {1.f, 1.f, 1.f, 1.f}, sn = {0.f, 0.f, 0.f, 0.f};
                    if (rope) { cs = *(const f32x4*)(cosT + s * 16 + 4 * fq); sn = *(const f32x4*)(sinT + s * 16 + 4 * fq); }
#pragma unroll
                    for (int bj = 0; bj < 2; ++bj) {
                        const int chunk = (pn & 3) * 2 + bj;
                        bf16_t* dst = qkv + (size_t)reg * (8192u * 1024u) + ((size_t)(b * 8 + chunk) * 4096 + s) * 128 + wc * 32 + 4 * fq;
                        f32x4 v0 = acc[ai][bj][m][0], v1 = acc[ai][bj][m][1];
                        if (rope) { const f32x4 a = v0 * cs - v1 * sn, bb = v0 * sn + v1 * cs; v0 = a; v1 = bb; }
                        st_bf16x4(dst, v0); st_bf16x4(dst + 16, v1);
                    }
                }
        } else {
            const int gi = (pn - 24) >> 3, colt = ((pn - 24) & 7) * BM;
#pragma unroll
            for (int ai = 0; ai < 2; ++ai)
#pragma unroll
                for (int m = 0; m < 4; ++m) {
                    const int row = u.pm * BM + ai * HALF + wr * 64 + m * 16 + fr;
                    bf16_t* rowp = gates + (size_t)gi * (8192u * 2048u) + (size_t)row * 2048 + colt + wc * 32 + 4 * fq;
#pragma unroll
                    for (int bj = 0; bj < 2; ++bj)
#pragma unroll
                        for (int n = 0; n < 2; ++n) { const f32x4 x = acc[ai][bj][m][n]; f32x4 y;
#pragma unroll
                            for (int j = 0; j < 4; ++j) y[j] = 1.0f / (1.0f + __expf(-x[j]));
                            st_bf16x4(rowp + bj * HALF + n * 16, y); }
                }
        }
    }
};
struct EpiBr1 {
    static constexpr bool PERM = false, AFTER_DRAIN = false;
    float* MF; const bf16_t* G;
    __device__ __forceinline__ void operator()(const f32x4 (&acc)[2][2][4][2], const Unit& u, int wr, int wc, int fr, int fq) const {
#pragma unroll
        for (int ai = 0; ai < 2; ++ai)
#pragma unroll
            for (int m = 0; m < 4; ++m) { const size_t off = (size_t)(u.pm * BM + ai * HALF + wr * 64 + m * 16 + fr) * 2048 + u.pn * BM + wc * 32 + 4 * fq;
#pragma unroll
                for (int bj = 0; bj < 2; ++bj)
#pragma unroll
                    for (int n = 0; n < 2; ++n) { const size_t o = off + bj * HALF + n * 16; *(f32x4*)(MF + o) = acc[ai][bj][m][n] * ld_bf16x4(G + o); } }
    }
};
struct EpiBr2 {
    static constexpr bool PERM = false, AFTER_DRAIN = false;
    const float* MF; bf16_t* MB; const bf16_t* G;
    __device__ __forceinline__ void operator()(const f32x4 (&acc)[2][2][4][2], const Unit& u, int wr, int wc, int fr, int fq) const {
#pragma unroll
        for (int ai = 0; ai < 2; ++ai)
#pragma unroll
            for (int m = 0; m < 4; ++m) { const size_t off = (size_t)(u.pm * BM + ai * HALF + wr * 64 + m * 16 + fr) * 2048 + u.pn * BM + wc * 32 + 4 * fq;
#pragma unroll
                for (int bj = 0; bj < 2; ++bj)
#pragma unroll
                    for (int n = 0; n < 2; ++n) { const size_t o = off + bj * HALF + n * 16; st_bf16x4(MB + o, *(const f32x4*)(MF + o) + acc[ai][bj][m][n] * ld_bf16x4(G + o)); } }
    }
};
struct EpiOut {
    static constexpr bool PERM = false, AFTER_DRAIN = false;
    const float* X; float* Y;
    __device__ __forceinline__ void operator()(const f32x4 (&acc)[2][2][4][2], const Unit& u, int wr, int wc, int fr, int fq) const {
#pragma unroll
        for (int ai = 0; ai < 2; ++ai)
#pragma unroll
            for (int m = 0; m < 4; ++m) { const size_t off = (size_t)(u.pm * BM + ai * HALF + wr * 64 + m * 16 + fr) * 2048 + u.pn * BM + wc * 32 + 4 * fq;
#pragma unroll
                for (int bj = 0; bj < 2; ++bj)
#pragma unroll
                    for (int n = 0; n < 2; ++n) { const size_t o = off + bj * HALF + n * 16; *(f32x4*)(Y + o) = *(const f32x4*)(X + o) * 1.4142135623730951f + acc[ai][bj][m][n]; } }
    }
};
struct EpiQ {
    static constexpr bool PERM = false, AFTER_DRAIN = false;
    bf16_t* O;
    __device__ __forceinline__ void operator()(const f32x4 (&acc)[2][2][4][2], const Unit& u, int wr, int wc, int fr, int fq) const {
#pragma unroll
        for (int ai = 0; ai < 2; ++ai)
#pragma unroll
            for (int m = 0; m < 4; ++m) { const size_t off = (size_t)(u.pm * BM + ai * HALF + wr * 64 + m * 16 + fr) * 2048 + u.pn * BM + wc * 32 + 4 * fq;
#pragma unroll
                for (int bj = 0; bj < 2; ++bj)
#pragma unroll
                    for (int n = 0; n < 2; ++n) st_bf16x4(O + off + bj * HALF + n * 16, acc[ai][bj][m][n]); }
    }
};

template <class Epi, class Sched, bool ALIGN_EPI = false, bool SP2 = false>
__device__ __forceinline__ void gemm_phase(PG8_LAS unsigned char* lds, const Gemm g, const Sched& S, const Epi& E) {
    const int tid = opq_tid(), wid = __builtin_amdgcn_readfirstlane(tid >> 6), lane = tid & 63, wr = wid >> 2, wc = wid & 3, fr = lane & 15, fq = lane >> 4;
    const int K = g.K, nt = K / BK;
    unsigned voffA[2], voffB[2];
#pragma unroll
    for (int i = 0; i < 2; ++i) { int R, C; stage_rc(tid * 16 + i * 8192, R, C); const int Rb = Epi::PERM ? ((R & ~31) + perm32(R & 31)) : R;
        voffA[i] = (unsigned)(R * K + C) * 2u; voffB[i] = (unsigned)(Rb * K + C) * 2u; }
    const size_t kstep = (size_t)(BK * 2);
    const size_t hstep = (size_t)HALF * K * 2;
    const size_t tstep = 2 * hstep;
    const unsigned ldsw = (unsigned)wid * 1024u;
    const int aoff = lds_byte(wr * 64 + fr, fq * 8), boff = lds_byte(wc * 32 + fr, fq * 8);
#define PG8_SA(b, h) (((b) * 2 + (h)) * HTB)
#define PG8_SB(b, h) ((4 + (b) * 2 + (h)) * HTB)
#define PG8_STAGE(bufoff, gbase, voff) do { _Pragma("unroll") for (int _i = 0; _i < 2; ++_i) \
        __builtin_amdgcn_global_load_lds((const unsigned*)((const char*)(gbase) + (voff)[_i]), (PG8_LAS unsigned*)(lds + (bufoff) + ldsw + _i * 8192), 16, 0, 0); } while (0)
#define PG8_LDA(dst, b, h) do { _Pragma("unroll") for (int m = 0; m < 4; ++m) _Pragma("unroll") for (int k = 0; k < 2; ++k) dst[m][k] = *(const PG8_LAS bf16x8*)(lds + PG8_SA(b, h) + aoff + m * 2048 + k * 1024); } while (0)
#define PG8_LDB(dst, b, h) do { _Pragma("unroll") for (int n = 0; n < 2; ++n) _Pragma("unroll") for (int k = 0; k < 2; ++k) dst[n][k] = *(const PG8_LAS bf16x8*)(lds + PG8_SB(b, h) + boff + n * 2048 + k * 1024); } while (0)
#define PG8_MMA(ai, bj, At, Bt) do { __builtin_amdgcn_s_setprio(1); _Pragma("unroll") for (int m = 0; m < 4; ++m) _Pragma("unroll") for (int n = 0; n < 2; ++n) _Pragma("unroll") for (int k = 0; k < 2; ++k) \
        acc[ai][bj][m][n] = __builtin_amdgcn_mfma_f32_16x16x32_bf16(Bt[n][k], At[m][k], acc[ai][bj][m][n], 0, 0, 0); __builtin_amdgcn_s_setprio(0); } while (0)
#define PG8_WAIT_V(n) asm volatile("s_waitcnt vmcnt(" #n ")" ::: "memory")
#define PG8_WAIT_L(n) asm volatile("s_waitcnt lgkmcnt(" #n ")" ::: "memory")
#define PG8_BAR __builtin_amdgcn_s_barrier()
#define PG8_SCHED __builtin_amdgcn_sched_barrier(0)
    Unit cur, nxt; int ui = 0;
    if (!S.next(0, cur)) return;
    f32x4 acc[2][2][4][2];
#pragma unroll
    for (int a = 0; a < 2; ++a)
#pragma unroll
        for (int b = 0; b < 2; ++b)
#pragma unroll
            for (int m = 0; m < 4; ++m)
#pragma unroll
                for (int n = 0; n < 2; ++n) acc[a][b][m][n] = (f32x4){0.f, 0.f, 0.f, 0.f};
    bf16x8 At[4][2], B0[2][2], B1[2][2];
    const char* cA = (const char*)g.A + (size_t)cur.pm * tstep; const char* cB = (const char*)g.Bt + (size_t)cur.pn * tstep;
    S.a_ready(cur);
    if constexpr (SP2) {
        PG8_STAGE(PG8_SB(0, 0), cB, voffB); PG8_STAGE(PG8_SB(0, 1), cB + hstep, voffB); PG8_STAGE(PG8_SA(0, 0), cA, voffA); PG8_STAGE(PG8_SA(0, 1), cA + hstep, voffA);
        if (wr == 1) PG8_BAR;
        PG8_WAIT_V(2); PG8_BAR;
        PG8_STAGE(PG8_SB(1, 0), cB + kstep, voffB); PG8_STAGE(PG8_SA(1, 0), cA + kstep, voffA); PG8_STAGE(PG8_SB(1, 1), cB + hstep + kstep, voffB);
        PG8_WAIT_V(6); PG8_BAR;
    } else {
        PG8_STAGE(PG8_SB(0, 0), cB, voffB); PG8_STAGE(PG8_SA(0, 0), cA, voffA); PG8_STAGE(PG8_SB(0, 1), cB + hstep, voffB); PG8_STAGE(PG8_SA(0, 1), cA + hstep, voffA);
        if (wr == 1) PG8_BAR;
        PG8_WAIT_V(4); PG8_BAR;
        PG8_STAGE(PG8_SB(1, 0), cB + kstep, voffB); PG8_STAGE(PG8_SA(1, 0), cA + kstep, voffA); PG8_STAGE(PG8_SB(1, 1), cB + hstep + kstep, voffB);
        PG8_WAIT_V(6); PG8_BAR;
    }
    for (;;) {
        const bool has_next = S.next(ui + 1, nxt);
        const char* nA = has_next ? (const char*)g.A + (size_t)nxt.pm * tstep : cA; const char* nB = has_next ? (const char*)g.Bt + (size_t)nxt.pn * tstep : cB;
        for (int t = 0; t < nt; t += 2) {
            const bool last = (t == nt - 2);
            const char* a1 = cA + (size_t)(t + 1) * kstep;
            const char* a2 = last ? nA : cA + (size_t)(t + 2) * kstep; const char* b2 = last ? nB : cB + (size_t)(t + 2) * kstep;
            const char* a3 = a2 + kstep; const char* b3 = b2 + kstep;
            if (last && has_next) S.a_ready(nxt);
            if constexpr (SP2) {
            PG8_LDB(B0, 0, 0); PG8_LDB(B1, 0, 1); PG8_SCHED; PG8_LDA(At, 0, 0); PG8_STAGE(PG8_SA(1, 1), a1 + hstep, voffA);
            PG8_WAIT_V(8); PG8_WAIT_L(0); PG8_BAR; PG8_MMA(0, 0, At, B0); PG8_MMA(0, 1, At, B1); PG8_BAR; PG8_SCHED;
            PG8_LDA(At, 0, 1); PG8_STAGE(PG8_SB(0, 0), b2, voffB); PG8_STAGE(PG8_SB(0, 1), b2 + hstep, voffB); PG8_STAGE(PG8_SA(0, 0), a2, voffA);
            PG8_WAIT_V(8); PG8_WAIT_L(0); PG8_BAR; PG8_MMA(1, 0, At, B0); PG8_MMA(1, 1, At, B1); PG8_BAR; PG8_SCHED;
            PG8_LDB(B0, 1, 0); PG8_LDB(B1, 1, 1); PG8_SCHED; PG8_LDA(At, 1, 0); PG8_STAGE(PG8_SA(0, 1), a2 + hstep, voffA);
            PG8_WAIT_V(8); PG8_WAIT_L(0); PG8_BAR; PG8_MMA(0, 0, At, B0); PG8_MMA(0, 1, At, B1); PG8_BAR; PG8_SCHED;
            PG8_LDA(At, 1, 1); PG8_STAGE(PG8_SB(1, 0), b3, voffB); PG8_STAGE(PG8_SB(1, 1), b3 + hstep, voffB); PG8_STAGE(PG8_SA(1, 0), a3, voffA);
            PG8_WAIT_V(8); PG8_WAIT_L(0); PG8_BAR; PG8_MMA(1, 0, At, B0); PG8_MMA(1, 1, At, B1); PG8_BAR; PG8_SCHED;
            } else {
            PG8_LDB(B0, 0, 0); PG8_SCHED; PG8_LDA(At, 0, 0); PG8_STAGE(PG8_SA(1, 1), a1 + hstep, voffA);
            PG8_WAIT_L(8); PG8_BAR; PG8_WAIT_L(0); PG8_MMA(0, 0, At, B0); PG8_BAR; PG8_SCHED;
            PG8_LDB(B1, 0, 1); PG8_STAGE(PG8_SB(0, 0), b2, voffB);
            PG8_BAR; PG8_WAIT_L(0); PG8_MMA(0, 1, At, B1); PG8_BAR;
            PG8_LDA(At, 0, 1); PG8_STAGE(PG8_SA(0, 0), a2, voffA);
            PG8_BAR; PG8_WAIT_L(0); PG8_MMA(1, 0, At, B0); PG8_BAR; PG8_SCHED;
            PG8_STAGE(PG8_SB(0, 1), b2 + hstep, voffB);
            PG8_WAIT_V(6); PG8_BAR; PG8_MMA(1, 1, At, B1); PG8_BAR;
            PG8_LDB(B0, 1, 0); PG8_SCHED; PG8_LDA(At, 1, 0); PG8_STAGE(PG8_SA(0, 1), a2 + hstep, voffA);
            PG8_WAIT_L(8); PG8_BAR; PG8_WAIT_L(0); PG8_MMA(0, 0, At, B0); PG8_BAR; PG8_SCHED;
            PG8_LDB(B1, 1, 1); PG8_STAGE(PG8_SB(1, 0), b3, voffB);
            PG8_BAR; PG8_WAIT_L(0); PG8_MMA(0, 1, At, B1); PG8_BAR;
            PG8_LDA(At, 1, 1); PG8_STAGE(PG8_SA(1, 0), a3, voffA);
            PG8_BAR; PG8_WAIT_L(0); PG8_MMA(1, 0, At, B0); PG8_BAR; PG8_SCHED;
            PG8_STAGE(PG8_SB(1, 1), b3 + hstep, voffB);
            PG8_WAIT_V(6); PG8_BAR; PG8_MMA(1, 1, At, B1); PG8_BAR;
            }
        }
        if constexpr (ALIGN_EPI) { if (wr == 0) PG8_BAR; }
        if constexpr (!Epi::AFTER_DRAIN) { E(acc, cur, wr, wc, fr, fq); S.done(cur); }
        if (!has_next) break;
#pragma unroll
        for (int a = 0; a < 2; ++a)
#pragma unroll
            for (int b = 0; b < 2; ++b)
#pragma unroll
                for (int m = 0; m < 4; ++m)
#pragma unroll
                    for (int n = 0; n < 2; ++n) acc[a][b][m][n] = (f32x4){0.f, 0.f, 0.f, 0.f};
        cur = nxt; cA = nA; cB = nB; ++ui;
        if constexpr (ALIGN_EPI) { if (wr == 1) PG8_BAR; }
    }
    PG8_WAIT_V(0);
    if constexpr (!ALIGN_EPI) { if (wr == 0) PG8_BAR; }
    PG8_BAR;
    if constexpr (Epi::AFTER_DRAIN) { E.fused(acc, cur, wr, wc, fr, fq, lds, wid, lane); S.done(cur); }
#undef PG8_SA
#undef PG8_SB
#undef PG8_STAGE
#undef PG8_LDA
#undef PG8_LDB
#undef PG8_MMA
#undef PG8_WAIT_V
#undef PG8_WAIT_L
#undef PG8_BAR
#undef PG8_SCHED
}
}
namespace att {
constexpr int D = 128; constexpr float THR = 8.f; constexpr bool WSKIP = false;
constexpr float SCALE = 0.08838834764831845f;
constexpr int NW = 8, QBLK = 32, KVBLK = 64, QB = NW * QBLK;
constexpr int SHM_V = KVBLK * D * 2, SHM_K = KVBLK * D * 2;
constexpr int LDS_BYTES = 2 * SHM_V + 2 * SHM_K + NW * 64 * 4;

typedef short bf16x8 __attribute__((ext_vector_type(8)));
typedef short s16x4 __attribute__((ext_vector_type(4)));
typedef float f32x16 __attribute__((ext_vector_type(16)));
typedef float f32x4 __attribute__((ext_vector_type(4)));
typedef unsigned u32x4 __attribute__((ext_vector_type(4)));
template <class A, class Bt> struct same_t { static constexpr bool v = false; };
template <class A> struct same_t<A, A> { static constexpr bool v = true; };

#define KSWZ(row, colB) ((row) * 256 + ((colB) ^ (((row) & 7) << 4)))
#define SBAR() __builtin_amdgcn_sched_barrier(0)
__device__ __forceinline__ int v_st(int k, int c) { const int kk = (k & ~0xC) | ((k & 4) << 1) | ((k & 8) >> 1); return ((kk >> 3) * 4 + (c >> 5)) * 512 + ((kk & 7) * 32 + (c & 31)) * 2; }
__device__ __forceinline__ int v_rd_base(int lane) { return ((lane & 3) << 3) | (((lane >> 2) & 3) << 6) | (((lane >> 4) & 1) << 5) | (((lane >> 5) & 1) << 8); }
constexpr int v_rd_off(int d0, int ks, int half) { return d0 * 512 + ks * 4096 + half * 2048; }
__device__ __forceinline__ int crow(int r, int hi) { return (r & 3) + 8 * (r >> 2) + 4 * hi; }
__device__ __forceinline__ unsigned cvtpk(float lo, float hi) {
    unsigned r; asm volatile("v_cvt_pk_bf16_f32 %0, %1, %2" : "=v"(r) : "v"(lo), "v"(hi)); return r;
}
__device__ __forceinline__ bf16x8 pack8(f32x4 a, f32x4 b) {
    u32x4 w = {cvtpk(a[0], a[1]), cvtpk(a[2], a[3]), cvtpk(b[0], b[1]), cvtpk(b[2], b[3])};
    return *reinterpret_cast<bf16x8*>(&w);
}
template <class T> __device__ __forceinline__ bf16x8 load8(const T* p) {
    if constexpr (same_t<T, float>::v) { return pack8(*(const f32x4*)p, *(const f32x4*)(p + 4)); }
    else { return *reinterpret_cast<const bf16x8*>(p); }
}
__device__ __forceinline__ void mask_tile(f32x16& p0, f32x16& p1, int dq, unsigned W) {
    const float NEG = -__builtin_inff();
#pragma unroll
    for (int r = 0; r < 16; ++r) {
        const int c = (r & 3) + 8 * (r >> 2);
        if ((unsigned)(dq - c) >= W) p0[r] = NEG;
        if ((unsigned)(dq - c - 32) >= W) p1[r] = NEG;
    }
}
__device__ __forceinline__ void partialSM(f32x16& p0, f32x16& p1, float& m_reg, float& mn, float& alpha) {
    float pmax = p0[0]; for (int r = 1; r < 16; ++r) pmax = fmaxf(pmax, p0[r]); for (int r = 0; r < 16; ++r) pmax = fmaxf(pmax, p1[r]);
    { auto rr = __builtin_amdgcn_permlane32_swap(__float_as_uint(pmax), __float_as_uint(pmax), false, false);
      pmax = fmaxf(__uint_as_float(rr[0]), __uint_as_float(rr[1])); }
    constexpr float C2 = 1.4426950408889634f * SCALE;
    if (__builtin_expect(__all((pmax - m_reg) * SCALE <= THR), 1)) { mn = m_reg; alpha = 1.f; }
    else { mn = fmaxf(m_reg, pmax); alpha = __builtin_amdgcn_exp2f((m_reg - mn) * C2); m_reg = mn; }
    const float mnL = -mn * C2;
    for (int r = 0; r < 16; ++r) p0[r] = fmaf(p0[r], C2, mnL); for (int r = 0; r < 16; ++r) p1[r] = fmaf(p1[r], C2, mnL);
    for (int r = 0; r < 16; ++r) p0[r] = __builtin_amdgcn_exp2f(p0[r]);
}
__device__ __forceinline__ void finishSM(f32x16& p0, f32x16& p1, float alpha, float& l_reg, bf16x8& pa0, bf16x8& pa1, bf16x8& pa2, bf16x8& pa3) {
    for (int r = 0; r < 16; ++r) p1[r] = __builtin_amdgcn_exp2f(p1[r]);
    float ps = 0; for (int r = 0; r < 16; ++r) ps += p0[r]; for (int r = 0; r < 16; ++r) ps += p1[r];
    { auto rr = __builtin_amdgcn_permlane32_swap(__float_as_uint(ps), __float_as_uint(ps), false, false);
      ps = __uint_as_float(rr[0]) + __uint_as_float(rr[1]); }
    l_reg = l_reg * alpha + ps;
#define PK4(P, B_, OUT) do { unsigned a0 = cvtpk(P[B_+0], P[B_+1]), a1 = cvtpk(P[B_+2], P[B_+3]);                          \
        unsigned b0 = cvtpk(P[B_+4], P[B_+5]), b1 = cvtpk(P[B_+6], P[B_+7]);                                             \
        auto r0 = __builtin_amdgcn_permlane32_swap(a0, b0, false, false); auto r1 = __builtin_amdgcn_permlane32_swap(a1, b1, false, false); \
        u32x4 w = {r0[0], r1[0], r0[1], r1[1]}; OUT = *reinterpret_cast<bf16x8*>(&w); } while (0)
    PK4(p0, 0, pa0); PK4(p0, 8, pa1); PK4(p1, 0, pa2); PK4(p1, 8, pa3);
#undef PK4
}
template <int KB, bool SK>
__device__ __forceinline__ void qkt(f32x16& p0, f32x16& p1, const char* K_lds, int r32, int hi, const bf16x8* qr, bool act) {
    if (SK && !act) { const float NEG = -__builtin_inff();
#pragma unroll
        for (int r = 0; r < 16; ++r) { p0[r] = NEG; p1[r] = NEG; } return; }
    p0 = f32x16{}; p1 = f32x16{};
    const char* kb[4];
#pragma unroll
    for (int dd = 0; dd < 4; ++dd) kb[dd] = K_lds + KB * SHM_K + KSWZ(r32, (dd * 16 + hi * 8) * 2);
#pragma unroll
    for (int d0 = 0; d0 < 8; ++d0) { const char* a = kb[d0 & 3] + (d0 >> 2) * 128;
        bf16x8 b0 = *reinterpret_cast<const bf16x8*>(a);
        bf16x8 b1 = *reinterpret_cast<const bf16x8*>(a + 32 * 256);
        p0 = __builtin_amdgcn_mfma_f32_32x32x16_bf16(b0, qr[d0], p0, 0, 0, 0);
        p1 = __builtin_amdgcn_mfma_f32_32x32x16_bf16(b1, qr[d0], p1, 0, 0, 0); }
}
template <int VB, bool SK>
__device__ __forceinline__ void pv_tile(f32x16* o, int vb0, bf16x8 pa0, bf16x8 pa1, bf16x8 pa2, bf16x8 pa3, bool act) {
    if (SK && !act) return;
#define TRRD(dst, off) asm volatile("ds_read_b64_tr_b16 %0, %1 offset:%2" : "=&v"(dst) : "v"(vb0), "i"(off) : "memory")
#define PV_D0(d0) do { s16x4 l0, l1, l2, l3, h0, h1, h2, h3; constexpr int b_ = VB * SHM_V + v_rd_off(d0, 0, 0);     \
        TRRD(l0, b_); TRRD(h0, b_ + 2048); TRRD(l1, b_ + 4096); TRRD(h1, b_ + 6144); TRRD(l2, b_ + 8192); TRRD(h2, b_ + 10240); TRRD(l3, b_ + 12288); TRRD(h3, b_ + 14336); \
        asm volatile("s_waitcnt lgkmcnt(0)" ::: "memory"); SBAR();                 \
        o[d0] = __builtin_amdgcn_mfma_f32_32x32x16_bf16(pa0, (bf16x8){l0[0], l0[1], l0[2], l0[3], h0[0], h0[1], h0[2], h0[3]}, o[d0], 0, 0, 0);   \
        o[d0] = __builtin_amdgcn_mfma_f32_32x32x16_bf16(pa1, (bf16x8){l1[0], l1[1], l1[2], l1[3], h1[0], h1[1], h1[2], h1[3]}, o[d0], 0, 0, 0);   \
        o[d0] = __builtin_amdgcn_mfma_f32_32x32x16_bf16(pa2, (bf16x8){l2[0], l2[1], l2[2], l2[3], h2[0], h2[1], h2[2], h2[3]}, o[d0], 0, 0, 0);   \
        o[d0] = __builtin_amdgcn_mfma_f32_32x32x16_bf16(pa3, (bf16x8){l3[0], l3[1], l3[2], l3[3], h3[0], h3[1], h3[2], h3[3]}, o[d0], 0, 0, 0); } while (0)
    PV_D0(0); PV_D0(1); PV_D0(2); PV_D0(3);
#undef PV_D0
#undef TRRD
}
template <class TIn, class TOut> struct BlockRef { const TIn* Q; const TIn* K; const TIn* V; TOut* O; int P0; int ostride; int moba; const float* kmean; };
template <class TIn> struct Seam {
    bf16x8 qr[8];
    bf16x8 st_v0, st_v1, st_k0, st_k1; f32x4 sf0, sf1, sf2, sf3;
    f32x4 tq[16];
};
__device__ __forceinline__ int swa_jlo(int P0, int W) { const int lowk = P0 - W + 1; return lowk > 0 ? lowk / KVBLK : 0; }
#define ROW(p, k0, rr) ((p) + (size_t)((k0) + (rr)) * D + sc)
#define VMW() asm volatile("s_waitcnt vmcnt(0)" ::: "memory")
#define VMWN(n) asm volatile("s_waitcnt vmcnt(%0)" :: "i"(n) : "memory")
#define SLOAD_H(Kp, Vp, k0) do { S.st_v0 = load8<TIn>(ROW(Vp, k0, sr)); S.st_v1 = load8<TIn>(ROW(Vp, k0, 32 + sr));              \
                         S.st_k0 = load8<TIn>(ROW(Kp, k0, sr)); S.st_k1 = load8<TIn>(ROW(Kp, k0, 32 + sr)); } while (0)
#define SWRITE_HK(bf) do { *(bf16x8*)(K_lds + (bf) * SHM_K + kws) = S.st_k0; *(bf16x8*)(K_lds + (bf) * SHM_K + kws + 32 * 256) = S.st_k1; } while (0)
#define SWRITE_HV(bf) do { *(bf16x8*)(V_lds + (bf) * SHM_V + vst0) = S.st_v0; *(bf16x8*)(V_lds + (bf) * SHM_V + vst1) = S.st_v1; } while (0)
#define SWRITE_H(bf) do { SWRITE_HV(bf); SWRITE_HK(bf); } while (0)
#define SLOAD_F(p, k0) do { S.sf0 = *(const f32x4*)ROW(p, k0, sr); S.sf1 = *(const f32x4*)(ROW(p, k0, sr) + 4);                \
                            S.sf2 = *(const f32x4*)ROW(p, k0, 32 + sr); S.sf3 = *(const f32x4*)(ROW(p, k0, 32 + sr) + 4); } while (0)
#define SWRITE_KF(bf) do { *(bf16x8*)(K_lds + (bf) * SHM_K + kws) = pack8(S.sf0, S.sf1); *(bf16x8*)(K_lds + (bf) * SHM_K + kws + 32 * 256) = pack8(S.sf2, S.sf3); } while (0)
#define SWRITE_VF(bf) do { *(bf16x8*)(V_lds + (bf) * SHM_V + vst0) = pack8(S.sf0, S.sf1); *(bf16x8*)(V_lds + (bf) * SHM_V + vst1) = pack8(S.sf2, S.sf3); } while (0)
template <class TIn, class TOut>
__device__ __forceinline__ void causal_swa_prime(const BlockRef<TIn, TOut>& cur, int W, char* lds, Seam<TIn>& S) {
    constexpr bool F32 = same_t<TIn, float>::v;
    const int tid = opq_tid(), wid = __builtin_amdgcn_readfirstlane(tid >> 6), lane = tid & 63, r32 = lane & 31, hi = lane >> 5;
    const int sr = tid >> 4, sc = (tid & 15) * 8, kws = KSWZ(sr, sc * 2); char* K_lds = lds + 2 * SHM_V;
    const int kb0 = swa_jlo(cur.P0, W) * KVBLK;
    for (int d0 = 0; d0 < 8; ++d0) S.qr[d0] = load8<TIn>(cur.Q + (size_t)(wid * QBLK + r32) * D + d0 * 16 + hi * 8);
    if constexpr (F32) { SLOAD_F((const float*)cur.K, kb0); VMW(); SWRITE_KF(0); SBAR(); SLOAD_F((const float*)cur.V, kb0); }
    else { SLOAD_H(cur.K, cur.V, kb0); VMW(); SWRITE_HK(0); }
    __syncthreads();
}
template <class TIn, class TOut>
__device__ __forceinline__ void causal_swa_block(const BlockRef<TIn, TOut>& cur, const BlockRef<TIn, TOut>& nxt, int skv, int W, char* lds, Seam<TIn>& S) {
    constexpr bool F32 = same_t<TIn, float>::v;
    const int tid = opq_tid(), wid = __builtin_amdgcn_readfirstlane(tid >> 6), lane = tid & 63, r32 = lane & 31, hi = lane >> 5;
    const int j_lo = swa_jlo(cur.P0, W);
    int j_hi = (cur.P0 + QB - 1) / KVBLK + 1; if (j_hi > skv / KVBLK) j_hi = skv / KVBLK;
    const int NT = j_hi - j_lo;
    const int kbn = swa_jlo(nxt.P0, W) * KVBLK;
    const int qlo = cur.P0 + wid * QBLK, qm = qlo + r32 - 4 * hi;
    char* V_lds = lds; char* K_lds = lds + 2 * SHM_V;
    float* ws = (float*)(lds + 2 * SHM_V + 2 * SHM_K) + wid * 64; float* li_l = ws, * al_l = ws + 32;
    float m_reg = -1e30f, l_reg = 0; f32x16 o[4] = {};
    const int sr = tid >> 4, sc = (tid & 15) * 8, vst0 = v_st(sr, sc), vst1 = v_st(32 + sr, sc), kws = KSWZ(sr, sc * 2);
    const int vb0 = (int)(uintptr_t)V_lds + v_rd_base(lane);
    const TIn* Kh = cur.K; const TIn* Vh = cur.V;
    const int own = cur.P0 >> 8; const int moba = cur.moba;
    unsigned selmask = 0xFFFFFFFFu;
    if (moba) {
        float qf[64];
#pragma unroll
        for (int d0 = 0; d0 < 8; ++d0)
#pragma unroll
            for (int j = 0; j < 8; ++j) qf[d0 * 8 + j] = __uint_as_float(((unsigned)(unsigned short)S.qr[d0][j]) << 16);
        float g1 = -3e38f, g2 = -3e38f, g3 = -3e38f; int i1 = -1, i2 = -1, i3 = -1;
        for (int n = 0; n < own; ++n) {
            const float* km = cur.kmean + n * 128 + hi * 8;
            float a0 = 0.f, a1 = 0.f;
#pragma unroll
            for (int d0 = 0; d0 < 8; ++d0) { const f32x4 k0 = *(const f32x4*)(km + d0 * 16), k1 = *(const f32x4*)(km + d0 * 16 + 4);
                a0 = fmaf(qf[d0 * 8 + 0], k0[0], a0); a0 = fmaf(qf[d0 * 8 + 1], k0[1], a0); a0 = fmaf(qf[d0 * 8 + 2], k0[2], a0); a0 = fmaf(qf[d0 * 8 + 3], k0[3], a0);
                a1 = fmaf(qf[d0 * 8 + 4], k1[0], a1); a1 = fmaf(qf[d0 * 8 + 5], k1[1], a1); a1 = fmaf(qf[d0 * 8 + 6], k1[2], a1); a1 = fmaf(qf[d0 * 8 + 7], k1[3], a1); }
            float a = a0 + a1; a += __shfl_xor(a, 32);
            const bool b1 = a > g1, b2 = a > g2, b3 = a > g3;
            g3 = b2 ? g2 : (b3 ? a : g3); i3 = b2 ? i2 : (b3 ? n : i3);
            g2 = b1 ? g1 : (b2 ? a : g2); i2 = b1 ? i1 : (b2 ? n : i2);
            g1 = b1 ? a : g1; i1 = b1 ? n : i1;
        }
        selmask = 0u; if (i1 >= 0) selmask |= 1u << i1; if (i2 >= 0) selmask |= 1u << i2; if (i3 >= 0) selmask |= 1u << i3;
    }
#define RESC(a) do { if (__any((a) < 1.f)) { if (hi == 0) al_l[r32] = (a); asm volatile("s_waitcnt lgkmcnt(0)" ::: "memory");              \
                     for (int d_ = 0; d_ < 4; ++d_) for (int r = 0; r < 16; ++r) o[d_][r] *= al_l[crow(r, hi)]; } } while (0)
#define KBASE(t) ((j_lo + (t)) * KVBLK)
#define ACT(t) (KBASE(t) <= qlo + QBLK - 1 && KBASE(t) + KVBLK - 1 >= qlo - W + 1)
#define MASKT(P0_, P1_, t) do { const int kb_ = KBASE(t); if ((!SK || ACT(t)) && (kb_ + KVBLK - 1 > qlo || kb_ <= qlo + QBLK - 1 - W)) mask_tile(P0_, P1_, qm - kb_, (unsigned)W); \
        if (moba && (kb_ >> 8) < own) { const bool keep_ = (selmask >> (kb_ >> 8)) & 1u; const float NEG_ = -__builtin_inff(); \
            _Pragma("unroll") for (int r_ = 0; r_ < 16; ++r_) { P0_[r_] = keep_ ? P0_[r_] : NEG_; P1_[r_] = keep_ ? P1_[r_] : NEG_; } } } while (0)
    constexpr int NQL = F32 ? 16 : 8;
    constexpr bool SK = WSKIP && !F32;
#define SEAM_K0() do { VMWN(NQL); if constexpr (F32) { SWRITE_KF(0); SBAR(); SLOAD_F((const float*)nxt.V, kbn); } else { SWRITE_HK(0); } SBAR(); } while (0)
    f32x16 pA0, pA1, pB0, pB1; float mnA, mnB, alA, alB; bf16x8 pa0, pa1, pa2, pa3;
    if constexpr (F32) { VMW(); SWRITE_VF(0); SBAR(); } else { SWRITE_HV(0); SBAR(); }
    if (NT > 1) { if constexpr (F32) SLOAD_F((const float*)Kh, KBASE(1)); else SLOAD_H(Kh, Vh, KBASE(1)); }
    SBAR(); qkt<0, SK>(pA0, pA1, K_lds, r32, hi, S.qr, ACT(0));
    if constexpr (F32) { if (NT > 1) { VMW(); SWRITE_KF(1); SBAR(); SLOAD_F((const float*)Vh, KBASE(1)); } }
    MASKT(pA0, pA1, 0); partialSM(pA0, pA1, m_reg, mnA, alA);
    if (NT > 1) { VMW(); if constexpr (F32) { SWRITE_VF(1); SBAR(); if (NT > 2) SLOAD_F((const float*)Kh, KBASE(2)); } else SWRITE_H(1); }
    __syncthreads();
#define HALF_STEP(PX0, PX1, mnX, alX, PY0, PY1, alY, t, KB, VB, SB) do {                                                      \
        SBAR(); qkt<KB, SK>(PX0, PX1, K_lds, r32, hi, S.qr, ACT(t));                                             \
        finishSM(PY0, PY1, alY, l_reg, pa0, pa1, pa2, pa3); SBAR();                                                           \
        if ((t) + 1 < NT) { if constexpr (F32) { VMW(); SWRITE_KF(SB); SBAR(); SLOAD_F((const float*)Vh, KBASE((t) + 1)); }  \
                            else { SLOAD_H(Kh, Vh, KBASE((t) + 1)); } SBAR(); }                                               \
        pv_tile<VB, SK>(o, vb0, pa0, pa1, pa2, pa3, ACT((t) - 1)); MASKT(PX0, PX1, (t)); partialSM(PX0, PX1, m_reg, mnX, alX);                                        \
        __syncthreads();                                                                                                      \
        if ((t) + 1 < NT) { VMW(); if constexpr (F32) { SWRITE_VF(SB); SBAR(); if ((t) + 2 < NT) SLOAD_F((const float*)Kh, KBASE((t) + 2)); } \
                            else { SWRITE_H(SB); } }                                                                          \
        RESC(alX); __syncthreads(); } while (0)
    for (int t = 1; t + 1 < NT; t += 2) {
        HALF_STEP(pB0, pB1, mnB, alB, pA0, pA1, alA, t, 1, 0, 0);
        HALF_STEP(pA0, pA1, mnA, alA, pB0, pB1, alB, t + 1, 0, 1, 1);
    }
    const bool even = (NT & 1) == 0;
    if (even) { SBAR(); qkt<1, SK>(pB0, pB1, K_lds, r32, hi, S.qr, ACT(NT - 1)); SBAR(); }
#define QROW(e) (nxt.Q + (size_t)(wid * QBLK + r32) * D + ((e) >> 1) * 16 + hi * 8 + ((e) & 1) * 4)
    if constexpr (F32) { SLOAD_F((const float*)nxt.K, kbn); SBAR();
#pragma unroll
        for (int e = 0; e < 8; ++e) S.tq[e] = *(const f32x4*)QROW(e); }
    else { SLOAD_H(nxt.K, nxt.V, kbn); SBAR();
#pragma unroll
        for (int d0 = 0; d0 < 8; ++d0) S.qr[d0] = load8<TIn>(nxt.Q + (size_t)(wid * QBLK + r32) * D + d0 * 16 + hi * 8); }
    SBAR();
    finishSM(pA0, pA1, alA, l_reg, pa0, pa1, pa2, pa3); SBAR();
    if constexpr (F32) {
#pragma unroll
        for (int e = 8; e < 16; ++e) S.tq[e] = *(const f32x4*)QROW(e); SBAR(); }
#undef QROW
    pv_tile<0, SK>(o, vb0, pa0, pa1, pa2, pa3, ACT(even ? NT - 2 : NT - 1));
    if (even) { MASKT(pB0, pB1, NT - 1); partialSM(pB0, pB1, m_reg, mnB, alB); __syncthreads(); RESC(alB);
        finishSM(pB0, pB1, alB, l_reg, pa0, pa1, pa2, pa3); SBAR(); pv_tile<1, SK>(o, vb0, pa0, pa1, pa2, pa3, ACT(NT - 1)); }
    SBAR(); SEAM_K0();
    if (hi == 0) li_l[r32] = l_reg; asm volatile("s_waitcnt lgkmcnt(0)" ::: "memory");
    float rli[16];
#pragma unroll
    for (int r = 0; r < 16; ++r) rli[r] = __builtin_amdgcn_rcpf(li_l[crow(r, hi)]);
    const int ostr = cur.ostride; TOut* Ow = cur.O + (size_t)(wid * QBLK) * ostr;
#pragma unroll
    for (int r = 0; r < 16; ++r) { const int orow = crow(r, hi);
#pragma unroll
        for (int d0 = 0; d0 < 4; ++d0) { const float v = o[d0][r] * rli[r];
            if constexpr (same_t<TOut, float>::v) { Ow[(size_t)orow * ostr + d0 * 32 + r32] = v; }
            else { const float vn = __shfl_xor(v, 1);
                   if ((r32 & 1) == 0) *(unsigned*)(Ow + (size_t)orow * ostr + d0 * 32 + r32) = cvtpk(v, vn); } } }
    if constexpr (F32) {
#pragma unroll
        for (int d0 = 0; d0 < 8; ++d0) S.qr[d0] = pack8(S.tq[2 * d0], S.tq[2 * d0 + 1]); }
    __syncthreads();
#undef RESC
#undef KBASE
#undef ACT
#undef MASKT
#undef SEAM_K0
#undef HALF_STEP
}
#undef ROW
#undef VMW
#undef VMWN
#undef SLOAD_H
#undef SWRITE_HK
#undef SWRITE_HV
#undef SWRITE_H
#undef SLOAD_F
#undef SWRITE_KF
#undef SWRITE_VF

}
#define GAS __attribute__((address_space(1)))
#define LAS __attribute__((address_space(3)))
typedef unsigned short bf16;
typedef unsigned v4u __attribute__((ext_vector_type(4)));
typedef float f32x4 __attribute__((ext_vector_type(4)));
typedef short bf16x8 __attribute__((ext_vector_type(8)));
typedef GAS unsigned gu32;
typedef GAS unsigned long long gu64;
#define RLX_AGENT __ATOMIC_RELAXED, __HIP_MEMORY_SCOPE_AGENT
#define LDS_WAIT() asm volatile("s_waitcnt lgkmcnt(0)" ::: "memory")
#define VM_WAIT() asm volatile("s_waitcnt vmcnt(0)" ::: "memory")
__device__ __forceinline__ unsigned long long rt() { return __builtin_amdgcn_s_memrealtime(); }
__device__ __forceinline__ unsigned f2bf(float f) { unsigned u = __builtin_bit_cast(unsigned, f); return (u + 0x7fffu + ((u >> 16) & 1u)) >> 16; }
__device__ __forceinline__ unsigned pk2(float lo, float hi) { return f2bf(lo) | (f2bf(hi) << 16); }

#define XB_TMO      128
#define XB_XCNT(j)  (256  + 64 * (j))
#define XB_XSUB(j)  (1280 + 64 * (j))
#define XB_XGEN(j)  (2304 + 64 * (j))
#define XB_TOP      3328
#define XB_TOPGEN   3392
#define XCD_BAR_WORDS 3456
#define XB_SPIN_CAP (1u << 18)

__device__ __forceinline__ unsigned xb_ld(unsigned* p)              { return __hip_atomic_load(p, __ATOMIC_RELAXED, __HIP_MEMORY_SCOPE_AGENT); }
__device__ __forceinline__ unsigned xb_add(unsigned* p, unsigned v) { return __hip_atomic_fetch_add(p, v, __ATOMIC_RELAXED, __HIP_MEMORY_SCOPE_AGENT); }
__device__ __forceinline__ unsigned xb_xcc_id() { return (unsigned)__builtin_amdgcn_s_getreg((3 << 11) | 20) & 0xFu; }
#define XB_SPIN(cond, bar) do { unsigned _sp = 0; while (cond) { __builtin_amdgcn_s_sleep(1); \
    if ((++_sp & 255u) == 0u) { if (xb_ld(&(bar)[XB_TMO])) break; if (_sp > XB_SPIN_CAP) { atomicAdd(&(bar)[XB_TMO], 1u); break; } } } } while (0)

struct XcdBarrier {
    unsigned* bar; unsigned x;
    volatile LAS unsigned* st;
};

__device__ __forceinline__ XcdBarrier xcd_barrier_post(unsigned* bar, volatile LAS unsigned* st) {
    XcdBarrier b; b.bar = bar; b.x = xb_xcc_id(); b.st = st;
    if (threadIdx.x == 0) (void)xb_add(&bar[XB_XCNT(b.x)], 1u);
    return b;
}
__device__ __forceinline__ void xcd_barrier_complete(unsigned* bar, unsigned x, unsigned& nloc, unsigned& nx) {
    const unsigned G = gridDim.x * gridDim.y * gridDim.z;
    unsigned sum, cnt, mine, sp = 0u;
    for (;;) {
        sum = 0u; cnt = 0u; mine = 0u;
#pragma unroll
        for (unsigned j = 0; j < 16; ++j) { const unsigned c = xb_ld(&bar[XB_XCNT(j)]); sum += c; cnt += (c > 0u) ? 1u : 0u; mine = (j == x) ? c : mine; }
        if (sum == G) break;
        __builtin_amdgcn_s_sleep(1);
        if ((++sp & 255u) == 0u) { if (xb_ld(&bar[XB_TMO])) break; if (sp > XB_SPIN_CAP) { atomicAdd(&bar[XB_TMO], 1u); break; } }
    }
    nloc = mine > 0u ? mine : 1u; nx = cnt > 0u ? cnt : 1u;
}

__device__ __forceinline__ void xcd_barrier(const XcdBarrier& b) {
    asm volatile("s_waitcnt vmcnt(0)" ::: "memory");
    __syncthreads();
    if (threadIdx.x == 0) {
        unsigned* bar = b.bar;
        __builtin_amdgcn_s_waitcnt(0);
        unsigned nloc = b.st[0], nx = b.st[1];
        if (nloc == 0u) { xcd_barrier_complete(bar, b.x, nloc, nx); b.st[0] = nloc; b.st[1] = nx; }
        const unsigned old = xb_add(&bar[XB_XSUB(b.x)], 1u);
        const unsigned gen = old / nloc;
        if (old + 1u == (gen + 1u) * nloc) {
            __builtin_amdgcn_fence(__ATOMIC_RELEASE, "agent");
            asm volatile("s_waitcnt vmcnt(0)" ::: "memory");
            const unsigned og = xb_add(&bar[XB_TOP], 1u);
            const unsigned tg = og / nx;
            if (og + 1u == (tg + 1u) * nx) xb_add(&bar[XB_TOPGEN], 1u);
            else XB_SPIN(xb_ld(&bar[XB_TOPGEN]) == tg, bar);
            __builtin_amdgcn_fence(__ATOMIC_ACQUIRE, "agent");
            xb_add(&bar[XB_XGEN(b.x)], 1u);
            asm volatile("s_waitcnt vmcnt(0)" ::: "memory");
        } else {
            XB_SPIN(xb_ld(&bar[XB_XGEN(b.x)]) == gen, bar);
            __builtin_amdgcn_fence(__ATOMIC_ACQUIRE, "agent");
            asm volatile("s_waitcnt vmcnt(0)" ::: "memory");
        }
    }
    __syncthreads();
}

constexpr int NWAVES = 8;
constexpr int BATCH = 2, SEQ = 4096, T = BATCH * SEQ, DM = 2048, DEPTH = 2;
constexpr int IN_COLS = 10240, NEXP = 16384;
constexpr float LN_EPS = 1e-5f, RMS_EPS = 1e-5f;
constexpr float DN_ALPHA = 1.4142135623730951f;

constexpr size_t MiB = 1u << 20;
constexpr size_t WS_CTL = 0, CTL_ZERO_BYTES = 1 * MiB;
constexpr size_t WS_ROPE = 1 * MiB;
constexpr size_t WS_KMEAN = 1 * MiB + 512 * 1024;
constexpr size_t WS_SUBK = 2 * MiB;
constexpr size_t WS_WIN = 4 * MiB;
constexpr size_t WS_WBM = 84 * MiB, WS_WBD = 92 * MiB;
constexpr size_t WS_WOUT = 100 * MiB, WS_WQ = 116 * MiB;
constexpr size_t WS_PU = 132 * MiB, WS_PV = 260 * MiB;
constexpr size_t WS_QKV = 388 * MiB;
constexpr size_t WS_GATES = 484 * MiB;
constexpr size_t WS_YM = 548 * MiB, WS_YD = 564 * MiB;
constexpr size_t WS_QP = 548 * MiB;
constexpr size_t WS_OD = 580 * MiB;
constexpr size_t WS_X1 = 580 * MiB;
constexpr size_t WS_MF = 644 * MiB;
constexpr size_t WS_MB = 708 * MiB;
constexpr size_t WS_X1B = 740 * MiB;
constexpr size_t WS_IDX = 772 * MiB, WS_GATE = 776 * MiB;
constexpr size_t WS_X2 = 780 * MiB;
constexpr size_t WS_XB = 844 * MiB;
constexpr size_t WS_END = 876 * MiB;

constexpr int CW_ATTQ = 64;
constexpr int CW_BAR = 4096;

constexpr int RING_OFF = 0, RING_BYTES = 131072;
constexpr int LDSCTL_OFF = RING_BYTES, MISC_OFF = LDSCTL_OFF + 320;
constexpr int LDS_BYTES = 147456;

struct Frame {
    LAS unsigned char* lds;
    volatile LAS unsigned* MISC;
    gu32* ctl;
    unsigned char* ws;
    int tid, lane, wave;
    int vcu, G;
    const float* in[15];
    float* out;
};
extern __shared__ __attribute__((aligned(16))) unsigned char lds_all[];
constexpr int CTX_OFF = MISC_OFF + 128;
__device__ __forceinline__ unsigned long long ctx_ld(int i) {
    volatile LAS unsigned* p = (volatile LAS unsigned*)((LAS unsigned char*)lds_all + CTX_OFF + 8 * i);
    const unsigned lo = __builtin_amdgcn_readfirstlane(p[0]), hi = __builtin_amdgcn_readfirstlane(p[1]);
    return ((unsigned long long)hi << 32) | lo;
}
__device__ __forceinline__ void mk_frame(Frame& F) {
    F.lds = (LAS unsigned char*)lds_all;
    F.MISC = (volatile LAS unsigned*)(F.lds + MISC_OFF);
    F.tid = opq_tid(); F.lane = F.tid & 63; F.wave = __builtin_amdgcn_readfirstlane(F.tid >> 6);
    F.G = gridDim.x; { const int bx = blockIdx.x; F.vcu = (F.G % 8 == 0) ? (bx % 8) * (F.G / 8) + bx / 8 : bx; }
#pragma unroll
    for (int i = 0; i < 15; ++i) F.in[i] = (const float*)ctx_ld(i);
    F.out = (float*)ctx_ld(15); F.ws = (unsigned char*)ctx_ld(16); F.ctl = (gu32*)(F.ws + WS_CTL);
}
__device__ __forceinline__ float wave_sum(float v) {
#pragma unroll
    for (int o = 1; o < 64; o <<= 1) v += __shfl_xor(v, o);
    return v;
}
__device__ __forceinline__ float bf2f(unsigned short h) { return __uint_as_float(((unsigned)h) << 16); }
__device__ __forceinline__ float bflo(unsigned w) { return __uint_as_float(w << 16); }
__device__ __forceinline__ float bfhi(unsigned w) { return __uint_as_float(w & 0xffff0000u); }

__device__ __forceinline__ void p0_transpose_item(const float* W, int K, int N, bf16* WT, int row_off, LAS float* scr, int item, int lane) {
    const int nblk = N / 32, kb = item / nblk, nb = item % nblk, k0 = 64 * kb, n0 = 32 * nb;
#pragma unroll 8
    for (int i = 0; i < 32; ++i) { const int kk = 2 * i + (lane >> 5); scr[kk * 33 + (lane & 31)] = W[(size_t)(k0 + kk) * N + n0 + (lane & 31)]; }
    LDS_WAIT(); asm volatile("" ::: "memory");
    const int c = lane & 7;
#pragma unroll
    for (int j = 0; j < 4; ++j) { const int n = (lane >> 3) + 8 * j; const LAS float* s = scr + (8 * c) * 33 + n;
        v4u o; o.x = pk2(s[0 * 33], s[1 * 33]); o.y = pk2(s[2 * 33], s[3 * 33]); o.z = pk2(s[4 * 33], s[5 * 33]); o.w = pk2(s[6 * 33], s[7 * 33]);
        *(GAS v4u*)(WT + (size_t)(row_off + n0 + n) * K + k0 + 8 * c) = o; }
    LDS_WAIT(); asm volatile("" ::: "memory");
}
__device__ __forceinline__ void convert_rows(const float* src, bf16* dst, size_t n8, size_t gtid, size_t nthr) {
    for (size_t i = gtid; i < n8; i += nthr) {
        const f32x4 a = *(const GAS f32x4*)(src + i * 8), b = *(const GAS f32x4*)(src + i * 8 + 4);
        v4u o; o.x = pk2(a[0], a[1]); o.y = pk2(a[2], a[3]); o.z = pk2(b[0], b[1]); o.w = pk2(b[2], b[3]);
        *(GAS v4u*)(dst + i * 8) = o; }
}
__device__ __forceinline__ void p0_prologue(Frame& F) {
    LAS float* scr = (LAS float*)(F.lds + RING_OFF + F.wave * 16384);
    const int gw = F.vcu * NWAVES + F.wave, NGW = F.G * NWAVES;
    constexpr int I_IN = (DM / 64) * (IN_COLS / 32), I_BR = (1024 / 64) * (DM / 32), I_SQ = (DM / 64) * (DM / 32);
    constexpr int I_LAYER = I_IN + 2 * I_BR + 2 * I_SQ, NITEMS = DEPTH * I_LAYER;
    for (int it = gw; it < NITEMS; it += NGW) {
        const int l = it / I_LAYER; int r = it % I_LAYER;
        if (r < I_IN) { p0_transpose_item(F.in[1] + (size_t)l * DM * IN_COLS, DM, IN_COLS, (bf16*)(F.ws + WS_WIN) + (size_t)l * IN_COLS * DM, 0, scr, r, F.lane); continue; } r -= I_IN;
        if (r < I_BR) { p0_transpose_item(F.in[2] + (size_t)l * 1024 * DM, 1024, DM, (bf16*)(F.ws + WS_WBM) + (size_t)l * DM * 1024, 0, scr, r, F.lane); continue; } r -= I_BR;
        if (r < I_BR) { p0_transpose_item(F.in[3] + (size_t)l * 1024 * DM, 1024, DM, (bf16*)(F.ws + WS_WBD) + (size_t)l * DM * 1024, 0, scr, r, F.lane); continue; } r -= I_BR;
        if (r < I_SQ) { p0_transpose_item(F.in[4] + (size_t)l * DM * DM, DM, DM, (bf16*)(F.ws + WS_WOUT) + (size_t)l * DM * DM, 0, scr, r, F.lane); continue; } r -= I_SQ;
        p0_transpose_item(F.in[9] + (size_t)l * DM * DM, DM, DM, (bf16*)(F.ws + WS_WQ) + (size_t)l * DM * DM, 0, scr, r, F.lane);
    }
    const size_t gtid = (size_t)F.vcu * (NWAVES * 64) + F.tid, nthr = (size_t)F.G * NWAVES * 64;
    convert_rows(F.in[11], (bf16*)(F.ws + WS_PU), (size_t)DEPTH * NEXP * DM / 8, gtid, nthr);
    convert_rows(F.in[12], (bf16*)(F.ws + WS_PV), (size_t)DEPTH * NEXP * DM / 8, gtid, nthr);
    convert_rows(F.in[10], (bf16*)(F.ws + WS_SUBK), (size_t)DEPTH * 8 * 2 * 128 * 128 / 8, gtid, nthr);
    convert_rows(F.in[0], (bf16*)(F.ws + WS_XB), (size_t)T * DM / 8, gtid, nthr);
    float* cosT = (float*)(F.ws + WS_ROPE); float* sinT = cosT + SEQ * 16;
    for (size_t i = gtid; i < (size_t)SEQ * 16; i += nthr) {
        const int pos = (int)(i >> 4), k = (int)(i & 15);
        const float inv = 1.0f / powf(500000.0f, (float)k * (1.0f / 16.0f));
        const float ang = (float)pos * inv;
        cosT[i] = (float)cos((double)ang); sinT[i] = (float)sin((double)ang);
    }
}

__device__ __forceinline__ void kmean_phase(Frame& F) {
    const bf16* KM = (const bf16*)(F.ws + WS_QKV) + (size_t)1 * T * 1024;
    float* KMEAN = (float*)(F.ws + WS_KMEAN);
    LAS float* red = (LAS float*)(F.lds + RING_OFF);
    const int cg = F.tid & 15, rg = F.tid >> 4;
    for (int it = F.vcu; it < 256; it += F.G) {
        const bf16* base = KM + ((size_t)(it >> 4) * SEQ + (size_t)(it & 15) * 256) * 128;
        float s[8] = {0, 0, 0, 0, 0, 0, 0, 0};
#pragma unroll
        for (int i = 0; i < 8; ++i) { const v4u w = *(const GAS v4u*)(base + (size_t)(rg * 8 + i) * 128 + cg * 8);
            s[0] += bflo(w.x); s[1] += bfhi(w.x); s[2] += bflo(w.y); s[3] += bfhi(w.y); s[4] += bflo(w.z); s[5] += bfhi(w.z); s[6] += bflo(w.w); s[7] += bfhi(w.w); }
#pragma unroll
        for (int j = 0; j < 8; ++j) red[rg * 128 + cg * 8 + j] = s[j];
        __syncthreads();
        if (F.tid < 128) { float a = 0.f;
#pragma unroll 8
            for (int g = 0; g < 32; ++g) a += red[g * 128 + F.tid];
            KMEAN[(size_t)it * 128 + F.tid] = a * (1.0f / 256.0f); }
        __syncthreads();
    }
}

struct AttItem { int valid; att::BlockRef<bf16, float> rf; int out_bf16; };
__device__ __forceinline__ int att_fetch(Frame& F, gu32* head) {
    if (F.tid == 0) F.MISC[0] = __hip_atomic_fetch_add(head, 1u, __ATOMIC_RELAXED, __HIP_MEMORY_SCOPE_AGENT);
    __syncthreads();
    const int v = (int)F.MISC[0];
    __syncthreads();
    return v;
}
template <class TOut>
__device__ __forceinline__ att::BlockRef<bf16, TOut> att_ref(Frame& F, int L) {
    att::BlockRef<bf16, TOut> r;
    const int qb = 15 - L / 48, rem = L % 48;
    const bf16* QKV = (const bf16*)(F.ws + WS_QKV); const size_t REG = (size_t)T * 1024;
    r.P0 = qb * 256;
    if constexpr (att::same_t<TOut, float>::v) {
        const int x = rem - 16, b = x >> 4, h = (x >> 2) & 3, comp = (x >> 1) & 1, half = x & 1;
        const size_t qk = ((size_t)(b * 8 + h * 2 + comp) * SEQ) * 128, vv = ((size_t)(b * 8 + h * 2 + half) * SEQ) * 128;
        r.Q = QKV + 3 * REG + qk + (size_t)qb * 256 * 128; r.K = QKV + 4 * REG + qk; r.V = QKV + 5 * REG + vv;
        r.O = (float*)(F.ws + WS_OD) + ((size_t)(((b * 4 + h) * 2 + comp) * 2 + half) * SEQ + (size_t)qb * 256) * 128;
        r.ostride = 128; r.moba = 0; r.kmean = nullptr;
    } else {
        const int b = rem >> 3, h = rem & 7;
        const size_t hh = ((size_t)(b * 8 + h) * SEQ) * 128;
        r.Q = QKV + hh + (size_t)qb * 256 * 128; r.K = QKV + 1 * REG + hh; r.V = QKV + 2 * REG + hh;
        r.O = (bf16*)(F.ws + WS_YM) + ((size_t)b * SEQ + (size_t)qb * 256) * 1024 + h * 128;
        r.ostride = 1024; r.moba = 1; r.kmean = (const float*)(F.ws + WS_KMEAN) + (size_t)(b * 8 + h) * 16 * 128;
    }
    return r;
}

__device__ __forceinline__ void diffcomb_phase(Frame& F, int l) {
    const float* lamf = F.in[5] + (size_t)l * 4 * 128; const float* sg = F.in[6] + (size_t)l * 256;
    const float lambda_init = 0.8f - 0.6f * expf(-0.3f * (float)l);
    const float d1 = wave_sum(lamf[F.lane] * lamf[128 + F.lane] + lamf[64 + F.lane] * lamf[128 + 64 + F.lane]);
    const float d2 = wave_sum(lamf[256 + F.lane] * lamf[384 + F.lane] + lamf[256 + 64 + F.lane] * lamf[384 + 64 + F.lane]);
    const float lam = expf(d1) - expf(d2) + lambda_init;
    const float* OD = (const float*)(F.ws + WS_OD); bf16* YD = (bf16*)(F.ws + WS_YD);
    const int gw = F.vcu * NWAVES + F.wave, NGW = F.G * NWAVES;
    const int half = F.lane >> 5, c4 = (F.lane & 31) * 4;
    const f32x4 g4 = *(const GAS f32x4*)(sg + half * 128 + c4);
    for (int it = gw; it < T * 4; it += NGW) {
        const int t = it >> 2, h = it & 3, b = t >> 12, s = t & 4095;
        const size_t o0 = ((size_t)(((b * 4 + h) * 2 + 0) * 2 + half) * SEQ + s) * 128 + c4;
        const size_t o1 = ((size_t)(((b * 4 + h) * 2 + 1) * 2 + half) * SEQ + s) * 128 + c4;
        const f32x4 a = *(const GAS f32x4*)(OD + o0), bb = *(const GAS f32x4*)(OD + o1);
        const f32x4 o = a - bb * lam;
        const float ss = wave_sum(o[0] * o[0] + o[1] * o[1] + o[2] * o[2] + o[3] * o[3]);
        const float rs = 1.0f / sqrtf(ss * (1.0f / 256.0f) + RMS_EPS) * (1.0f - lambda_init);
        const f32x4 y = o * rs * g4;
        unsigned long long pk = (unsigned long long)pk2(y[0], y[1]) | ((unsigned long long)pk2(y[2], y[3]) << 32);
        *(GAS unsigned long long*)(YD + (size_t)t * 1024 + h * 256 + half * 128 + c4) = pk;
    }
}

__device__ __forceinline__ void ln1_phase(Frame& F, int l) {
    const float* Y = (const float*)(F.ws + WS_MF); float* X1 = (float*)(F.ws + WS_X1); bf16* X1B = (bf16*)(F.ws + WS_X1B);
    const float* g = F.in[7] + (size_t)l * DM; const float* bta = F.in[8] + (size_t)l * DM;
    const int gw = F.vcu * NWAVES + F.wave, NGW = F.G * NWAVES;
    for (int m = gw; m < T; m += NGW) {
        const GAS f32x4* xr = (const GAS f32x4*)(Y + (size_t)m * DM) + F.lane;
        f32x4 v[8]; float s = 0.f;
#pragma unroll
        for (int j = 0; j < 8; ++j) { v[j] = xr[64 * j]; s += (v[j].x + v[j].y) + (v[j].z + v[j].w); }
        const float mean = wave_sum(s) * (1.f / DM); float s2 = 0.f;
#pragma unroll
        for (int j = 0; j < 8; ++j) { v[j] = v[j] - mean; s2 += (v[j].x * v[j].x + v[j].y * v[j].y) + (v[j].z * v[j].z + v[j].w * v[j].w); }
        const float rstd = 1.f / sqrtf(wave_sum(s2) * (1.f / DM) + LN_EPS);
        GAS f32x4* of = (GAS f32x4*)(X1 + (size_t)m * DM) + F.lane;
        GAS unsigned long long* o8 = (GAS unsigned long long*)(X1B + (size_t)m * DM) + F.lane;
#pragma unroll
        for (int j = 0; j < 8; ++j) { const f32x4 gg = ((const GAS f32x4*)g)[F.lane + 64 * j], bb = ((const GAS f32x4*)bta)[F.lane + 64 * j];
            const f32x4 y = v[j] * rstd * gg + bb; of[64 * j] = y;
            o8[64 * j] = (unsigned long long)pk2(y.x, y.y) | ((unsigned long long)pk2(y.z, y.w) << 32); }
    }
}

__device__ __forceinline__ unsigned mkkey(float f, unsigned low, unsigned mask) {
    unsigned u = __float_as_uint(f); u = (u & 0x80000000u) ? ~u : (u | 0x80000000u); return (u & ~mask) | low; }
__device__ __forceinline__ float keyval(unsigned k, unsigned mask) {
    const unsigned u = k & ~mask; return __uint_as_float((u & 0x80000000u) ? (u & 0x7fffffffu) : ~u); }
#define INS16(L, key_) do { unsigned k_ = (key_); _Pragma("unroll") for (int i_ = 0; i_ < 16; ++i_) { const unsigned h_ = max(L[i_], k_); k_ = min(L[i_], k_); L[i_] = h_; } } while (0)
__device__ __forceinline__ void bitonic_desc16(unsigned (&C)[16]) {
#pragma unroll
    for (int d = 8; d >= 1; d >>= 1)
#pragma unroll
        for (int i = 0; i < 16; ++i) if ((i & d) == 0) { const unsigned a = max(C[i], C[i + d]), b = min(C[i], C[i + d]); C[i] = a; C[i + d] = b; }
}
__device__ __forceinline__ void peer_topk_phase(Frame& F, int l) {
    typedef float f32x16 __attribute__((ext_vector_type(16)));
    const bf16* QP = (const bf16*)(F.ws + WS_QP); const bf16* SK = (const bf16*)(F.ws + WS_SUBK) + (size_t)l * 8 * 2 * 128 * 128;
    int* IDX = (int*)(F.ws + WS_IDX); float* GATE = (float*)(F.ws + WS_GATE);
    const int gw = F.vcu * NWAVES + F.wave, NGW = F.G * NWAVES;
    const int r32 = F.lane & 31, hi = F.lane >> 5;
    for (int it = gw; it < 2048; it += NGW) {
        const int h = it >> 8, g = it & 255, t = g * 32 + r32;
        unsigned LA[16], LB[16];
#pragma unroll
        for (int c = 0; c < 2; ++c) {
            bf16x8 qf[8];
#pragma unroll
            for (int d0 = 0; d0 < 8; ++d0) qf[d0] = *(const GAS bf16x8*)(QP + (size_t)t * DM + h * 256 + c * 128 + d0 * 16 + hi * 8);
            unsigned L[16];
#pragma unroll
            for (int i = 0; i < 16; ++i) L[i] = 0u;
#pragma unroll
            for (int nt = 0; nt < 4; ++nt) {
                f32x16 p = {0, 0, 0, 0, 0, 0, 0, 0, 0, 0, 0, 0, 0, 0, 0, 0};
                const bf16* kr = SK + ((size_t)(h * 2 + c) * 128 + nt * 32 + r32) * 128 + hi * 8;
#pragma unroll
                for (int d0 = 0; d0 < 8; ++d0) { const bf16x8 kf = *(const GAS bf16x8*)(kr + d0 * 16);
                    p = __builtin_amdgcn_mfma_f32_32x32x16_bf16(kf, qf[d0], p, 0, 0, 0); }
#pragma unroll
                for (int r = 0; r < 16; ++r) { const int n = nt * 32 + (r & 3) + 8 * (r >> 2) + 4 * hi;
                    INS16(L, mkkey(p[r], (unsigned)(127 - n), 127u)); }
            }
            unsigned C[16];
#pragma unroll
            for (int i = 0; i < 16; ++i) { const unsigned o = (unsigned)__shfl_xor((int)L[15 - i], 32); C[i] = max(L[i], o); }
            bitonic_desc16(C);
#pragma unroll
            for (int i = 0; i < 16; ++i) { if (c == 0) LA[i] = C[i]; else LB[i] = C[i]; }
        }
        float a[16], b[16];
#pragma unroll
        for (int i = 0; i < 16; ++i) { a[i] = keyval(LA[i], 127u); b[i] = keyval(LB[i], 127u); }
        unsigned M[16];
#pragma unroll
        for (int i = 0; i < 16; ++i) M[i] = 0u;
#pragma unroll
        for (int i = 0; i < 16; ++i)
#pragma unroll
            for (int j = 0; j < 16; ++j) if ((i + 1) * (j + 1) <= 16) INS16(M, mkkey(a[i] + b[j], (unsigned)(255 - (i * 16 + j)), 255u));
        float e[16]; float se = 0.f; const float m0 = keyval(M[0], 255u);
#pragma unroll
        for (int k = 0; k < 16; ++k) { e[k] = __expf(keyval(M[k], 255u) - m0); se += e[k]; }
        const float inv = 1.0f / se;
        int ex[8]; float gt[8];
#pragma unroll
        for (int kk = 0; kk < 8; ++kk) {
            const unsigned mk = hi ? M[8 + kk] : M[kk]; gt[kk] = (hi ? e[8 + kk] : e[kk]) * inv;
            const int code = 255 - (int)(mk & 255u), ci = code >> 4, cj = code & 15;
            unsigned ka = 0u, kb = 0u;
#pragma unroll
            for (int q = 0; q < 16; ++q) { ka = (ci == q) ? LA[q] : ka; kb = (cj == q) ? LB[q] : kb; }
            ex[kk] = (127 - (int)(ka & 127u)) * 128 + (127 - (int)(kb & 127u));
        }
        int* ip = IDX + (size_t)t * 128 + h * 16 + hi * 8; float* gp = GATE + (size_t)t * 128 + h * 16 + hi * 8;
        *(GAS v4u*)ip = (v4u){(unsigned)ex[0], (unsigned)ex[1], (unsigned)ex[2], (unsigned)ex[3]};
        *(GAS v4u*)(ip + 4) = (v4u){(unsigned)ex[4], (unsigned)ex[5], (unsigned)ex[6], (unsigned)ex[7]};
        *(GAS f32x4*)gp = (f32x4){gt[0], gt[1], gt[2], gt[3]};
        *(GAS f32x4*)(gp + 4) = (f32x4){gt[4], gt[5], gt[6], gt[7]};
    }
}

typedef __attribute__((__vector_size__(2 * sizeof(__bf16)))) __bf16 bf16x2_t;
__device__ __forceinline__ float dot2bf(unsigned a, unsigned b, float acc) {
    return __builtin_amdgcn_fdot2_f32_bf16(__builtin_bit_cast(bf16x2_t, a), __builtin_bit_cast(bf16x2_t, b), acc, false); }
__device__ __forceinline__ float gelu_exact(float x) { return 0.5f * x * (1.0f + erff(x * 0.70710678118654752f)); }
__device__ __forceinline__ void peer_expert_phase(Frame& F, int l, const float* xres, float* xout, bf16* xoutb) {
    const bf16* PU = (const bf16*)(F.ws + WS_PU) + (size_t)l * NEXP * DM; const bf16* PV = (const bf16*)(F.ws + WS_PV) + (size_t)l * NEXP * DM;
    const bf16* X1B = (const bf16*)(F.ws + WS_X1B);
    const int* IDX = (const int*)(F.ws + WS_IDX); const float* GATE = (const float*)(F.ws + WS_GATE);
    const float* g = F.in[13] + (size_t)l * DM; const float* bta = F.in[14] + (size_t)l * DM;
    const int gw = F.vcu * NWAVES + F.wave, NGW = F.G * NWAVES;
    for (int t = gw; t < T; t += NGW) {
        v4u xr[4];
#pragma unroll
        for (int j = 0; j < 4; ++j) xr[j] = *(const GAS v4u*)(X1B + (size_t)t * DM + (F.lane + 64 * j) * 8);
        const int id0 = IDX[(size_t)t * 128 + F.lane], id1 = IDX[(size_t)t * 128 + 64 + F.lane];
        const float g0 = GATE[(size_t)t * 128 + F.lane], g1 = GATE[(size_t)t * 128 + 64 + F.lane];
        float c0 = 0.f, c1 = 0.f;
        for (int e0 = 0; e0 < 128; e0 += 4) {
            v4u w[4][4];
#pragma unroll
            for (int k = 0; k < 4; ++k) { const int e = e0 + k; const int row = __builtin_amdgcn_readlane(e < 64 ? id0 : id1, e & 63);
                const bf16* ur = PU + (size_t)row * DM;
#pragma unroll
                for (int j = 0; j < 4; ++j) w[k][j] = *(const GAS v4u*)(ur + (F.lane + 64 * j) * 8); }
#pragma unroll
            for (int k = 0; k < 4; ++k) { const int e = e0 + k;
                float s0 = 0.f, s1 = 0.f, s2 = 0.f, s3 = 0.f;
#pragma unroll
                for (int j = 0; j < 4; ++j) { s0 = dot2bf(w[k][j].x, xr[j].x, s0); s1 = dot2bf(w[k][j].y, xr[j].y, s1); s2 = dot2bf(w[k][j].z, xr[j].z, s2); s3 = dot2bf(w[k][j].w, xr[j].w, s3); }
                const float tot = wave_sum((s0 + s1) + (s2 + s3));
                const float act = gelu_exact(tot);
                if (e < 64) { if (F.lane == (e & 63)) c0 = g0 * act; } else { if (F.lane == (e & 63)) c1 = g1 * act; }
            }
        }
        float acc[32];
#pragma unroll
        for (int i = 0; i < 32; ++i) acc[i] = 0.f;
        for (int e0 = 0; e0 < 128; e0 += 4) {
            v4u w[4][4]; float cc[4];
#pragma unroll
            for (int k = 0; k < 4; ++k) { const int e = e0 + k; const int row = __builtin_amdgcn_readlane(e < 64 ? id0 : id1, e & 63);
                cc[k] = __uint_as_float(__builtin_amdgcn_readlane(__float_as_uint(e < 64 ? c0 : c1), e & 63));
                const bf16* vr = PV + (size_t)row * DM;
#pragma unroll
                for (int j = 0; j < 4; ++j) w[k][j] = *(const GAS v4u*)(vr + (F.lane + 64 * j) * 8); }
#pragma unroll
            for (int k = 0; k < 4; ++k) { const float c = cc[k];
#pragma unroll
                for (int j = 0; j < 4; ++j) {
                    acc[j * 8 + 0] = fmaf(c, bflo(w[k][j].x), acc[j * 8 + 0]); acc[j * 8 + 1] = fmaf(c, bfhi(w[k][j].x), acc[j * 8 + 1]);
                    acc[j * 8 + 2] = fmaf(c, bflo(w[k][j].y), acc[j * 8 + 2]); acc[j * 8 + 3] = fmaf(c, bfhi(w[k][j].y), acc[j * 8 + 3]);
                    acc[j * 8 + 4] = fmaf(c, bflo(w[k][j].z), acc[j * 8 + 4]); acc[j * 8 + 5] = fmaf(c, bfhi(w[k][j].z), acc[j * 8 + 5]);
                    acc[j * 8 + 6] = fmaf(c, bflo(w[k][j].w), acc[j * 8 + 6]); acc[j * 8 + 7] = fmaf(c, bfhi(w[k][j].w), acc[j * 8 + 7]); }
            }
        }
        float s = 0.f;
#pragma unroll
        for (int j = 0; j < 4; ++j) { const f32x4 x0 = *(const GAS f32x4*)(xres + (size_t)t * DM + (F.lane + 64 * j) * 8), x1 = *(const GAS f32x4*)(xres + (size_t)t * DM + (F.lane + 64 * j) * 8 + 4);
#pragma unroll
            for (int i = 0; i < 4; ++i) { acc[j * 8 + i] = fmaf(DN_ALPHA, x0[i], acc[j * 8 + i]); acc[j * 8 + 4 + i] = fmaf(DN_ALPHA, x1[i], acc[j * 8 + 4 + i]); }
#pragma unroll
            for (int i = 0; i < 8; ++i) s += acc[j * 8 + i]; }
        const float mean = wave_sum(s) * (1.f / DM); float s2 = 0.f;
#pragma unroll
        for (int i = 0; i < 32; ++i) { acc[i] -= mean; s2 = fmaf(acc[i], acc[i], s2); }
        const float rstd = 1.f / sqrtf(wave_sum(s2) * (1.f / DM) + LN_EPS);
#pragma unroll
        for (int j = 0; j < 4; ++j) { const int col = (F.lane + 64 * j) * 8;
            const f32x4 ga = *(const GAS f32x4*)(g + col), gb = *(const GAS f32x4*)(g + col + 4), ba = *(const GAS f32x4*)(bta + col), bb = *(const GAS f32x4*)(bta + col + 4);
            f32x4 y0, y1;
#pragma unroll
            for (int i = 0; i < 4; ++i) { y0[i] = acc[j * 8 + i] * rstd * ga[i] + ba[i]; y1[i] = acc[j * 8 + 4 + i] * rstd * gb[i] + bb[i]; }
            *(GAS f32x4*)(xout + (size_t)t * DM + col) = y0; *(GAS f32x4*)(xout + (size_t)t * DM + col + 4) = y1;
            if (xoutb) { v4u o; o.x = pk2(y0[0], y0[1]); o.y = pk2(y0[2], y0[3]); o.z = pk2(y1[0], y1[1]); o.w = pk2(y1[2], y1[3]); *(GAS v4u*)(xoutb + (size_t)t * DM + col) = o; }
        }
    }
}

constexpr int N_PHASES = 1 + 10 * DEPTH;
#ifndef MK_ONE_LAUNCH
#define MK_ONE_LAUNCH 0
#endif
struct Args { const float* in[15]; float* out; unsigned char* ws; int ph_lo, ph_hi; };
__global__ void __launch_bounds__(NWAVES * 64, 2) mk_fwd(Args args) {
    {
        LAS unsigned char* L = (LAS unsigned char*)lds_all; const int tid = threadIdx.x;
        for (int u = tid; u < (LDS_BYTES - LDSCTL_OFF) / 4; u += NWAVES * 64) ((LAS unsigned*)(L + LDSCTL_OFF))[u] = 0u;
        __syncthreads();
        if (tid < 17) { const unsigned long long v = tid < 15 ? (unsigned long long)args.in[tid] : (tid == 15 ? (unsigned long long)args.out : (unsigned long long)args.ws);
            ((LAS unsigned long long*)(L + CTX_OFF))[tid] = v; }
        __syncthreads();
        if (MK_ONE_LAUNCH) (void)xcd_barrier_post((unsigned*)((gu32*)(args.ws + WS_CTL) + CW_BAR), (volatile LAS unsigned*)(L + MISC_OFF) + 8);
    }
    const int lo = args.ph_lo, hi = args.ph_hi;
#define IN(k) (lo <= (k) && (k) < hi)
#ifndef PHM
#define PHM 0xFFFF
#endif
#define PHM_ON(k) (((PHM) >> (k)) & 1)
#define SEAM(k) do { if (IN(k) && IN((k) + 1)) { XcdBarrier bar_; bar_.bar = (unsigned*)((gu32*)((unsigned char*)ctx_ld(16) + WS_CTL) + CW_BAR); bar_.x = xb_xcc_id(); \
        bar_.st = (volatile LAS unsigned*)((LAS unsigned char*)lds_all + MISC_OFF) + 8; xcd_barrier(bar_); } } while (0)

    if (PHM_ON(0) && IN(0)) { Frame F; mk_frame(F); p0_prologue(F); }
    SEAM(0);

    for (int l = 0; l < DEPTH; ++l) {
        const int pb = 1 + 10 * l;
        if (PHM_ON(1) && IN(pb + 0)) { Frame F; mk_frame(F);
            pg8::Gemm g{(const bf16*)(F.ws + WS_XB), (const bf16*)(F.ws + WS_WIN) + (size_t)l * IN_COLS * DM, T, IN_COLS, DM};
            pg8::StaticOrder S; S.init(T, IN_COLS, F.G, (int)blockIdx.x);
            pg8::EpiIn E{(bf16*)(F.ws + WS_QKV), (bf16*)(F.ws + WS_GATES), (const float*)(F.ws + WS_ROPE), (const float*)(F.ws + WS_ROPE) + SEQ * 16};
            pg8::gemm_phase<pg8::EpiIn, pg8::StaticOrder, true, true>(F.lds + RING_OFF, g, S, E);
        }
        SEAM(pb + 0);
        if (PHM_ON(2) && IN(pb + 1)) { Frame F; mk_frame(F); kmean_phase(F); }
        SEAM(pb + 1);
        if (PHM_ON(3) && IN(pb + 2)) { Frame F; mk_frame(F);
            gu32* head = F.ctl + CW_ATTQ + 64 * l;
            int L = att_fetch(F, head);
            while (L < 768) {
                const int Ln = att_fetch(F, head);
                const bool is_moba = (L % 48) < 16;
                if (is_moba) {
                    att::Seam<bf16> Sm;
                    const att::BlockRef<bf16, bf16> cur = att_ref<bf16>(F, L);
                    att::causal_swa_prime<bf16, bf16>(cur, SEQ, (char*)lds_all + RING_OFF, Sm);
                    att::causal_swa_block<bf16, bf16>(cur, cur, SEQ, SEQ, (char*)lds_all + RING_OFF, Sm);
                } else {
                    att::Seam<bf16> Sm;
                    const att::BlockRef<bf16, float> cur = att_ref<float>(F, L);
                    att::causal_swa_prime<bf16, float>(cur, SEQ, (char*)lds_all + RING_OFF, Sm);
                    att::causal_swa_block<bf16, float>(cur, cur, SEQ, SEQ, (char*)lds_all + RING_OFF, Sm);
                }
                L = Ln;
            }
        }
        SEAM(pb + 2);
        if (PHM_ON(4) && IN(pb + 3)) { Frame F; mk_frame(F); diffcomb_phase(F, l); }
        SEAM(pb + 3);
        if (PHM_ON(5) && IN(pb + 4)) {
            { Frame F; mk_frame(F); pg8::StaticOrder S; S.init(T, DM, F.G, (int)blockIdx.x);
              pg8::Gemm g{(const bf16*)(F.ws + WS_YM), (const bf16*)(F.ws + WS_WBM) + (size_t)l * DM * 1024, T, DM, 1024};
              pg8::EpiBr1 E{(float*)(F.ws + WS_MF), (const bf16*)(F.ws + WS_GATES)};
              pg8::gemm_phase<pg8::EpiBr1, pg8::StaticOrder, false, true>(F.lds + RING_OFF, g, S, E); }
            { Frame F; mk_frame(F); pg8::StaticOrder S; S.init(T, DM, F.G, (int)blockIdx.x);
              pg8::Gemm g{(const bf16*)(F.ws + WS_YD), (const bf16*)(F.ws + WS_WBD) + (size_t)l * DM * 1024, T, DM, 1024};
              pg8::EpiBr2 E{(const float*)(F.ws + WS_MF), (bf16*)(F.ws + WS_MB), (const bf16*)(F.ws + WS_GATES) + (size_t)T * DM};
              pg8::gemm_phase<pg8::EpiBr2, pg8::StaticOrder, false, true>(F.lds + RING_OFF, g, S, E); }
        }
        SEAM(pb + 4);
        if (PHM_ON(6) && IN(pb + 5)) { Frame F; mk_frame(F);
            const float* xres = (l == 0) ? F.in[0] : (const float*)(F.ws + WS_X2);
            pg8::Gemm g{(const bf16*)(F.ws + WS_MB), (const bf16*)(F.ws + WS_WOUT) + (size_t)l * DM * DM, T, DM, DM};
            pg8::StaticOrder S; S.init(T, DM, F.G, (int)blockIdx.x);
            pg8::EpiOut E{xres, (float*)(F.ws + WS_MF)};
            pg8::gemm_phase<pg8::EpiOut, pg8::StaticOrder, false, true>(F.lds + RING_OFF, g, S, E);
        }
        SEAM(pb + 5);
        if (PHM_ON(7) && IN(pb + 6)) { Frame F; mk_frame(F); ln1_phase(F, l); }
        SEAM(pb + 6);
        if (PHM_ON(8) && IN(pb + 7)) { Frame F; mk_frame(F);
            pg8::Gemm g{(const bf16*)(F.ws + WS_X1B), (const bf16*)(F.ws + WS_WQ) + (size_t)l * DM * DM, T, DM, DM};
            pg8::StaticOrder S; S.init(T, DM, F.G, (int)blockIdx.x);
            pg8::EpiQ E{(bf16*)(F.ws + WS_QP)};
            pg8::gemm_phase<pg8::EpiQ, pg8::StaticOrder, false, true>(F.lds + RING_OFF, g, S, E);
        }
        SEAM(pb + 7);
        if (PHM_ON(9) && IN(pb + 8)) { Frame F; mk_frame(F); peer_topk_phase(F, l); }
        SEAM(pb + 8);
        if (PHM_ON(10) && IN(pb + 9)) { Frame F; mk_frame(F);
            peer_expert_phase(F, l, (const float*)(F.ws + WS_X1), (l == DEPTH - 1) ? F.out : (float*)(F.ws + WS_X2), (l == DEPTH - 1) ? (bf16*)nullptr : (bf16*)(F.ws + WS_XB)); }
        SEAM(pb + 9);
    }
#undef IN
#undef SEAM
}

extern "C" void kernel_launch(void* const* d_in, const int* in_sizes, int n_in, void* d_out, int out_size, void* d_ws, size_t ws_size, hipStream_t stream) {
    static int grid = 0;
    if (grid == 0) {
        if (n_in != 15 || in_sizes[0] != T * DM || out_size != T * DM || ws_size < WS_END) {
            fprintf(stderr, "kernel_launch: expected 15 inputs, x/out of %d floats, >= %zu bytes of workspace; got n_in %d in0 %d out %d ws %zu\n", T * DM, (size_t)WS_END, n_in, n_in > 0 ? in_sizes[0] : -1, out_size, ws_size);
            grid = -1; return; }
        int dev = 0, cus = 0, per_cu = 0;
        if (hipGetDevice(&dev) != hipSuccess || hipDeviceGetAttribute(&cus, hipDeviceAttributeMultiprocessorCount, dev) != hipSuccess) { grid = -1; return; }
        if (hipFuncSetAttribute((const void*)mk_fwd, hipFuncAttributeMaxDynamicSharedMemorySize, LDS_BYTES) != hipSuccess) { fprintf(stderr, "kernel_launch: hipFuncSetAttribute failed\n"); grid = -1; return; }
        if (hipOccupancyMaxActiveBlocksPerMultiprocessor(&per_cu, (const void*)mk_fwd, NWAVES * 64, LDS_BYTES) != hipSuccess || per_cu < 1)
            fprintf(stderr, "kernel_launch: occupancy query reports %d workgroups per CU\n", per_cu);
        (void)hipGetLastError();
        grid = cus;
    }
    if (grid < 0) return;
    if (hipMemsetAsync((char*)d_ws + WS_CTL, 0, CTL_ZERO_BYTES, stream) != hipSuccess) { fprintf(stderr, "kernel_launch: memset failed\n"); return; }
    Args a{};
    for (int i = 0; i < 15; ++i) a.in[i] = (const float*)d_in[i];
    a.out = (float*)d_out; a.ws = (unsigned char*)d_ws;
    if (MK_ONE_LAUNCH) {
        a.ph_lo = 0; a.ph_hi = N_PHASES;
        hipLaunchKernelGGL(mk_fwd, dim3(grid), dim3(NWAVES * 64), LDS_BYTES, stream, a);
    } else {
        for (int p = 0; p < N_PHASES; ++p) { a.ph_lo = p; a.ph_hi = p + 1; hipLaunchKernelGGL(mk_fwd, dim3(grid), dim3(NWAVES * 64), LDS_BYTES, stream, a); }
    }
    const hipError_t le = hipPeekAtLastError();
    if (le != hipSuccess) fprintf(stderr, "kernel_launch: launch failed: %s\n", hipGetErrorName(le));
}
```

```cpp
#include <hip/hip_runtime.h>
#include <cstdio>
#include <cstdint>
#define MK_ONE_LAUNCH 1
#define REPM 0
#define PEER_PROBE 0
#define BAR_PROBE 0
#define FP8_EMU 0
#define SP2_SMALL true
#define SP2_IN true
#define FP4_EMU 0
#define PEER_W4 0
__device__ __forceinline__ int opq_tid(int wave_s) { int l; asm volatile("v_mbcnt_lo_u32_b32 %0, -1, 0\n\tv_mbcnt_hi_u32_b32 %0, -1, %0" : "=v"(l)); return (wave_s << 6) | l; }
namespace pg8 {
#define PG8_LAS __attribute__((address_space(3)))
typedef unsigned short bf16_t;
typedef short bf16x8 __attribute__((ext_vector_type(8)));
typedef float f32x4 __attribute__((ext_vector_type(4)));
typedef unsigned u32x4 __attribute__((ext_vector_type(4)));
constexpr int BM = 256, BK = 64, HALF = 128, HTB = HALF * BK * 2  , STAGE_BYTES = 8 * HTB, NXCD = 8, WGM = 8;

__host__ __device__ __forceinline__ int lds_byte(int r, int c) { const int st = (r >> 4) * 2 + (c >> 5), rr = r & 15, cc = c & 31, ob = rr * 64 + cc * 2; return st * 1024 + (ob ^ (((ob >> 9) & 1) << 5)); }
__host__ __device__ __forceinline__ void stage_rc(int b, int& R, int& C) { const int st = b / 1024, sb = b % 1024, swz = sb ^ (((sb >> 9) & 1) << 5); R = (st >> 1) * 16 + swz / 64; C = (st & 1) * 32 + (swz % 64) / 2; }
__host__ __device__ __forceinline__ int perm32(int rho) { const int n = rho >> 4, i = rho & 15; return 8 * (i >> 2) + 4 * n + (i & 3); }

struct Unit { int pm, pn, kb; };
struct Gemm { const bf16_t* A; const bf16_t* Bt; int M, N, K, ld; };

struct StaticOrder {
    int nM, nN, nwg, G, c;
    __host__ __device__ __forceinline__ void init(int M, int N, int G_, int c_) { nM = M / BM; nN = N / BM; nwg = nM * nN; G = G_; c = c_; }
    __host__ __device__ __forceinline__ bool next(int i, Unit& u) const {
        const long L = (long)i * G + c; if (L >= nwg) return false;
        int wgid = (int)L; { const int q = nwg / NXCD, r = nwg % NXCD, xcd = wgid % NXCD, off = wgid / NXCD; wgid = (xcd < r ? xcd * (q + 1) : r * (q + 1) + (xcd - r) * q) + off; }
        const int nig = WGM * nN, gid = wgid / nig, fm = gid * WGM, gsz = (nM - fm) < WGM ? (nM - fm) : WGM;
        u.pm = fm + ((wgid % nig) % gsz); u.pn = (wgid % nig) / gsz; u.kb = 0; return true;
    }
    __device__ __forceinline__ void a_ready(const Unit&) const {}
    __device__ __forceinline__ void done(const Unit&) const {}
};
__device__ __forceinline__ unsigned cvt_pk_bf16(float lo, float hi) { unsigned r; asm volatile("v_cvt_pk_bf16_f32 %0, %1, %2" : "=v"(r) : "v"(lo), "v"(hi)); return r; }
__device__ __forceinline__ void st_bf16x4(bf16_t* p, f32x4 v) {
    const unsigned long long w = (unsigned long long)cvt_pk_bf16(v[0], v[1]) | ((unsigned long long)cvt_pk_bf16(v[2], v[3]) << 32);
    *(unsigned long long*)p = w;
}
__device__ __forceinline__ void st_bf16x4_nt(bf16_t* p, f32x4 v) {
    const unsigned long long w = (unsigned long long)cvt_pk_bf16(v[0], v[1]) | ((unsigned long long)cvt_pk_bf16(v[2], v[3]) << 32);
    __builtin_nontemporal_store(w, (__attribute__((address_space(1))) unsigned long long*)p);
}
__device__ __forceinline__ f32x4 cvt_bf16x4(unsigned long long w) {
    const unsigned lo = (unsigned)w, hi = (unsigned)(w >> 32);
    return (f32x4){__uint_as_float(lo << 16), __uint_as_float(lo & 0xffff0000u), __uint_as_float(hi << 16), __uint_as_float(hi & 0xffff0000u)};
}
__device__ __forceinline__ f32x4 ld_bf16x4(const bf16_t* p) {
    const unsigned long long w = *(const unsigned long long*)p; const unsigned lo = (unsigned)w, hi = (unsigned)(w >> 32);
    return (f32x4){__uint_as_float(lo << 16), __uint_as_float(lo & 0xffff0000u), __uint_as_float(hi << 16), __uint_as_float(hi & 0xffff0000u)};
}
struct EpiIn {
    static constexpr bool PERM = false, AFTER_DRAIN = false, MIDK = false;
    bf16_t* qkv; bf16_t* gates; const float* cosT; const float* sinT;
    __device__ __forceinline__ void operator()(const f32x4 (&acc)[2][2][4][2], const Unit& u, int wr, int wc, int fr, int fq) const {
        const int pn = u.pn;
        if (pn < 24) {
            const int reg = pn >> 2;
            const bool rope = (reg == 0 || reg == 1 || reg == 3 || reg == 4) && (wc == 0);
            f32x4 csv[8], snv[8];
#pragma unroll
            for (int q = 0; q < 8; ++q) { csv[q] = (f32x4){1.f, 1.f, 1.f, 1.f}; snv[q] = (f32x4){0.f, 0.f, 0.f, 0.f}; }
            if (rope) {
#pragma unroll
                for (int q = 0; q < 8; ++q) { const int s = (u.pm * BM + (q >> 2) * HALF + wr * 64 + (q & 3) * 16 + fr) & 4095;
                    csv[q] = *(const f32x4*)(cosT + s * 16 + 4 * fq); snv[q] = *(const f32x4*)(sinT + s * 16 + 4 * fq); }
                asm volatile("" : "+v"(csv[0]), "+v"(csv[1]), "+v"(csv[2]), "+v"(csv[3]), "+v"(csv[4]), "+v"(csv[5]), "+v"(csv[6]), "+v"(csv[7]),
                                  "+v"(snv[0]), "+v"(snv[1]), "+v"(snv[2]), "+v"(snv[3]), "+v"(snv[4]), "+v"(snv[5]), "+v"(snv[6]), "+v"(snv[7]));
            }
#pragma unroll
            for (int ai = 0; ai < 2; ++ai)
#pragma unroll
                for (int m = 0; m < 4; ++m) {
                    const int row = u.pm * BM + ai * HALF + wr * 64 + m * 16 + fr, b = row >> 12, s = row & 4095;
                    const f32x4 cs = csv[ai * 4 + m], sn = snv[ai * 4 + m];
#pragma unroll
                    for (int bj = 0; bj < 2; ++bj) {
                        const int chunk = (pn & 3) * 2 + bj;
                        bf16_t* dst = qkv + (size_t)reg * (8192u * 1024u) + ((size_t)(b * 8 + chunk) * 4096 + s) * 128 + wc * 32 + 4 * fq;
                        f32x4 v0 = acc[ai][bj][m][0], v1 = acc[ai][bj][m][1];
                        if (rope) { const f32x4 a = v0 * cs - v1 * sn, bb = v0 * sn + v1 * cs; v0 = a; v1 = bb; }
                        st_bf16x4(dst, v0); st_bf16x4(dst + 16, v1);
                    }
                }
        } else {
            const int gi = (pn - 24) >> 3, colt = ((pn - 24) & 7) * BM;
#pragma unroll
            for (int ai = 0; ai < 2; ++ai)
#pragma unroll
                for (int m = 0; m < 4; ++m) {
                    const int row = u.pm * BM + ai * HALF + wr * 64 + m * 16 + fr;
                    bf16_t* rowp = gates + (size_t)gi * (8192u * 2048u) + (size_t)row * 2048 + colt + wc * 32 + 4 * fq;
#pragma unroll
                    for (int bj = 0; bj < 2; ++bj)
#pragma unroll
                        for (int n = 0; n < 2; ++n) { const f32x4 x = acc[ai][bj][m][n]; f32x4 y;
#pragma unroll
                            for (int j = 0; j < 4; ++j) y[j] = 1.0f / (1.0f + __expf(-x[j]));
                            st_bf16x4_nt(rowp + bj * HALF + n * 16, y); }
                }
        }
    }
};
struct EpiBr {
    static constexpr bool PERM = false, AFTER_DRAIN = false, MIDK = true;
    bf16_t* MB; const bf16_t* GM; const bf16_t* GD;
    __device__ __forceinline__ void mid(f32x4 (&acc)[2][2][4][2], const Unit& u, int wr, int wc, int fr, int fq) const {
#pragma unroll
        for (int ai = 0; ai < 2; ++ai)
#pragma unroll
            for (int m = 0; m < 4; ++m) { const size_t off = (size_t)(u.pm * BM + ai * HALF + wr * 64 + m * 16 + fr) * 2048 + u.pn * BM + wc * 32 + 4 * fq;
                unsigned long long gmw[4], gdw[4];
#pragma unroll
                for (int q = 0; q < 4; ++q) { const size_t o = off + (q >> 1) * HALF + (q & 1) * 16; gmw[q] = *(const unsigned long long*)(GM + o); gdw[q] = *(const unsigned long long*)(GD + o); }
                asm volatile("" : "+v"(gmw[0]), "+v"(gmw[1]), "+v"(gmw[2]), "+v"(gmw[3]), "+v"(gdw[0]), "+v"(gdw[1]), "+v"(gdw[2]), "+v"(gdw[3]));
#pragma unroll
                for (int q = 0; q < 4; ++q) { const f32x4 gm = cvt_bf16x4(gmw[q]), gd = cvt_bf16x4(gdw[q]); f32x4 r;
#pragma unroll
                    for (int j = 0; j < 4; ++j) r[j] = gm[j] * __builtin_amdgcn_rcpf(gd[j]);
                    acc[ai][q >> 1][m][q & 1] = acc[ai][q >> 1][m][q & 1] * r; }
                asm volatile("" ::: "memory"); }
    }
    __device__ __forceinline__ void operator()(const f32x4 (&acc)[2][2][4][2], const Unit& u, int wr, int wc, int fr, int fq) const {
#pragma unroll
        for (int a2 = 0; a2 < 4; ++a2) {
            unsigned long long gdw[8];
#pragma unroll
            for (int q = 0; q < 8; ++q) { const int g = 2 * a2 + (q >> 2), ai = g >> 2, m = g & 3;
                const size_t o = (size_t)(u.pm * BM + ai * HALF + wr * 64 + m * 16 + fr) * 2048 + u.pn * BM + wc * 32 + 4 * fq + ((q >> 1) & 1) * HALF + (q & 1) * 16;
                gdw[q] = *(const unsigned long long*)(GD + o); }
            asm volatile("" : "+v"(gdw[0]), "+v"(gdw[1]), "+v"(gdw[2]), "+v"(gdw[3]), "+v"(gdw[4]), "+v"(gdw[5]), "+v"(gdw[6]), "+v"(gdw[7]));
#pragma unroll
            for (int q = 0; q < 8; ++q) { const int g = 2 * a2 + (q >> 2), ai = g >> 2, m = g & 3;
                const size_t o = (size_t)(u.pm * BM + ai * HALF + wr * 64 + m * 16 + fr) * 2048 + u.pn * BM + wc * 32 + 4 * fq + ((q >> 1) & 1) * HALF + (q & 1) * 16;
                st_bf16x4(MB + o, acc[ai][(q >> 1) & 1][m][q & 1] * cvt_bf16x4(gdw[q])); }
        }
    }
};
struct EpiOut {
    static constexpr bool PERM = false, AFTER_DRAIN = false, MIDK = false;
    const float* X; const bf16_t* XB; bf16_t* YB; float* RS;
    __device__ __forceinline__ void operator()(const f32x4 (&acc)[2][2][4][2], const Unit& u, int wr, int wc, int fr, int fq) const {
#pragma unroll
        for (int a2 = 0; a2 < 4; ++a2) {
            f32x4 xr[8];
            if (X) {
#pragma unroll
                for (int q = 0; q < 8; ++q) { const int g = 2 * a2 + (q >> 2), ai = g >> 2, m = g & 3;
                    const size_t o = (size_t)(u.pm * BM + ai * HALF + wr * 64 + m * 16 + fr) * 2048 + u.pn * BM + wc * 32 + 4 * fq + ((q >> 1) & 1) * HALF + (q & 1) * 16;
                    xr[q] = *(const f32x4*)(X + o); }
                asm volatile("" : "+v"(xr[0]), "+v"(xr[1]), "+v"(xr[2]), "+v"(xr[3]), "+v"(xr[4]), "+v"(xr[5]), "+v"(xr[6]), "+v"(xr[7]));
            } else {
                unsigned long long xw[8];
#pragma unroll
                for (int q = 0; q < 8; ++q) { const int g = 2 * a2 + (q >> 2), ai = g >> 2, m = g & 3;
                    const size_t o = (size_t)(u.pm * BM + ai * HALF + wr * 64 + m * 16 + fr) * 2048 + u.pn * BM + wc * 32 + 4 * fq + ((q >> 1) & 1) * HALF + (q & 1) * 16;
                    xw[q] = *(const unsigned long long*)(XB + o); }
                asm volatile("" : "+v"(xw[0]), "+v"(xw[1]), "+v"(xw[2]), "+v"(xw[3]), "+v"(xw[4]), "+v"(xw[5]), "+v"(xw[6]), "+v"(xw[7]));
#pragma unroll
                for (int q = 0; q < 8; ++q) xr[q] = cvt_bf16x4(xw[q]);
            }
#pragma unroll
            for (int gg = 0; gg < 2; ++gg) { const int g = 2 * a2 + gg, ai = g >> 2, m = g & 3; const int row = u.pm * BM + ai * HALF + wr * 64 + m * 16 + fr;
                const size_t off = (size_t)row * 2048 + u.pn * BM + wc * 32 + 4 * fq;
                float s1 = 0.f, s2 = 0.f;
#pragma unroll
                for (int bj = 0; bj < 2; ++bj)
#pragma unroll
                    for (int n = 0; n < 2; ++n) { const size_t o = off + bj * HALF + n * 16;
                        const f32x4 y = xr[gg * 4 + bj * 2 + n] * 1.4142135623730951f + acc[ai][bj][m][n]; st_bf16x4(YB + o, y);
                        s1 += (y[0] + y[1]) + (y[2] + y[3]); s2 += (y[0] * y[0] + y[1] * y[1]) + (y[2] * y[2] + y[3] * y[3]); }
                s1 += __shfl_xor(s1, 16); s1 += __shfl_xor(s1, 32); s2 += __shfl_xor(s2, 16); s2 += __shfl_xor(s2, 32);
                if (fq == 0) { float* p = RS + (size_t)row * 64 + (u.pn * 4 + wc) * 2; p[0] = s1; p[1] = s2; } }
        }
    }
};
struct EpiQ {
    static constexpr bool PERM = false, AFTER_DRAIN = false, MIDK = false;
    bf16_t* O; const PG8_LAS float* tab;
    __device__ __forceinline__ void operator()(const f32x4 (&acc)[2][2][4][2], const Unit& u, int wr, int wc, int fr, int fq) const {
        const int lc0 = wc * 32 + 4 * fq;
#pragma unroll
        for (int ai = 0; ai < 2; ++ai)
#pragma unroll
            for (int m = 0; m < 4; ++m) { const int lr = ai * HALF + wr * 64 + m * 16 + fr; const size_t off = (size_t)(u.pm * BM + lr) * 2048 + u.pn * BM + lc0;
                const float rstd = tab[256 + lr], rm = rstd * tab[lr];
#pragma unroll
                for (int bj = 0; bj < 2; ++bj)
#pragma unroll
                    for (int n = 0; n < 2; ++n) { const int lc = lc0 + bj * HALF + n * 16; const f32x4 c1 = *(const PG8_LAS f32x4*)(tab + 512 + lc), c2 = *(const PG8_LAS f32x4*)(tab + 768 + lc);
                        st_bf16x4(O + off + bj * HALF + n * 16, acc[ai][bj][m][n] * rstd - c1 * rm + c2); } }
    }
};
struct PairOrder {
    StaticOrder base; int kb2;
    __host__ __device__ __forceinline__ void init(int M, int N, int G_, int c_, int kb2_) { base.init(M, N, G_, c_); kb2 = kb2_; }
    __host__ __device__ __forceinline__ bool next(int i, Unit& u) const { if (!base.next(i >> 1, u)) return false; u.kb = (i & 1) ? kb2 : 0; return true; }
    __device__ __forceinline__ void a_ready(const Unit&) const {}
    __device__ __forceinline__ void done(const Unit&) const {}
};

template <class Epi, class Sched, bool ALIGN_EPI = false, bool SP2 = false>
__device__ __forceinline__ void gemm_phase(PG8_LAS unsigned char* lds, const Gemm g, const Sched& S, const Epi& E, const int wave_s__) {
    const int tid = opq_tid(wave_s__), wid = __builtin_amdgcn_readfirstlane(tid >> 6), lane = tid & 63, wr = wid >> 2, wc = wid & 3, fr = lane & 15, fq = lane >> 4;
    const int K = g.ld, nt = g.K / BK;
    unsigned voffA[2], voffB[2];
#pragma unroll
    for (int i = 0; i < 2; ++i) { int R, C; stage_rc(tid * 16 + i * 8192, R, C); const int Rb = Epi::PERM ? ((R & ~31) + perm32(R & 31)) : R;
        voffA[i] = (unsigned)(R * K + C) * 2u; voffB[i] = (unsigned)(Rb * K + C) * 2u; }
    const size_t kstep = (size_t)(BK * 2);
    const size_t hstep = (size_t)HALF * K * 2;
    const size_t tstep = 2 * hstep;
    const unsigned ldsw = (unsigned)wid * 1024u;
    const int aoff = lds_byte(wr * 64 + fr, fq * 8), boff = lds_byte(wc * 32 + fr, fq * 8);
#define PG8_SA(b, h) (((b) * 2 + (h)) * HTB)
#define PG8_SB(b, h) ((4 + (b) * 2 + (h)) * HTB)
#define PG8_STAGE(bufoff, gbase, voff) do { _Pragma("unroll") for (int _i = 0; _i < 2; ++_i) \
        __builtin_amdgcn_global_load_lds((const unsigned*)((const char*)(gbase) + (voff)[_i]), (PG8_LAS unsigned*)(lds + (bufoff) + ldsw + _i * 8192), 16, 0, 0); } while (0)
#define PG8_LDA(dst, b, h) do { _Pragma("unroll") for (int m = 0; m < 4; ++m) _Pragma("unroll") for (int k = 0; k < 2; ++k) dst[m][k] = *(const PG8_LAS bf16x8*)(lds + PG8_SA(b, h) + aoff + m * 2048 + k * 1024); } while (0)
#define PG8_LDB(dst, b, h) do { _Pragma("unroll") for (int n = 0; n < 2; ++n) _Pragma("unroll") for (int k = 0; k < 2; ++k) dst[n][k] = *(const PG8_LAS bf16x8*)(lds + PG8_SB(b, h) + boff + n * 2048 + k * 1024); } while (0)
#define PG8_MMA(ai, bj, At, Bt) do { __builtin_amdgcn_s_setprio(1); _Pragma("unroll") for (int m = 0; m < 4; ++m) _Pragma("unroll") for (int n = 0; n < 2; ++n) _Pragma("unroll") for (int k = 0; k < 2; ++k) \
        acc[ai][bj][m][n] = __builtin_amdgcn_mfma_f32_16x16x32_bf16(Bt[n][k], At[m][k], acc[ai][bj][m][n], 0, 0, 0); __builtin_amdgcn_s_setprio(0); } while (0)
#define PG8_WAIT_V(n) asm volatile("s_waitcnt vmcnt(" #n ")" ::: "memory")
#define PG8_WAIT_L(n) asm volatile("s_waitcnt lgkmcnt(" #n ")" ::: "memory")
#define PG8_BAR __builtin_amdgcn_s_barrier()
#define PG8_SCHED __builtin_amdgcn_sched_barrier(0)
    Unit cur, nxt; int ui = 0;
    if (!S.next(0, cur)) return;
    f32x4 acc[2][2][4][2];
#pragma unroll
    for (int a = 0; a < 2; ++a)
#pragma unroll
        for (int b = 0; b < 2; ++b)
#pragma unroll
            for (int m = 0; m < 4; ++m)
#pragma unroll
                for (int n = 0; n < 2; ++n) acc[a][b][m][n] = (f32x4){0.f, 0.f, 0.f, 0.f};
    bf16x8 At[4][2], B0[2][2], B1[2][2];
    const char* cA = (const char*)g.A + (size_t)cur.pm * tstep + cur.kb; const char* cB = (const char*)g.Bt + (size_t)cur.pn * tstep + cur.kb;
    S.a_ready(cur);
    if constexpr (SP2) {
        PG8_STAGE(PG8_SB(0, 0), cB, voffB); PG8_STAGE(PG8_SB(0, 1), cB + hstep, voffB); PG8_STAGE(PG8_SA(0, 0), cA, voffA); PG8_STAGE(PG8_SA(0, 1), cA + hstep, voffA);
        if (wr == 1) PG8_BAR;
        PG8_WAIT_V(2); PG8_BAR;
        PG8_STAGE(PG8_SB(1, 0), cB + kstep, voffB); PG8_STAGE(PG8_SA(1, 0), cA + kstep, voffA); PG8_STAGE(PG8_SB(1, 1), cB + hstep + kstep, voffB);
        PG8_WAIT_V(6); PG8_BAR;
    } else {
        PG8_STAGE(PG8_SB(0, 0), cB, voffB); PG8_STAGE(PG8_SA(0, 0), cA, voffA); PG8_STAGE(PG8_SB(0, 1), cB + hstep, voffB); PG8_STAGE(PG8_SA(0, 1), cA + hstep, voffA);
        if (wr == 1) PG8_BAR;
        PG8_WAIT_V(4); PG8_BAR;
        PG8_STAGE(PG8_SB(1, 0), cB + kstep, voffB); PG8_STAGE(PG8_SA(1, 0), cA + kstep, voffA); PG8_STAGE(PG8_SB(1, 1), cB + hstep + kstep, voffB);
        PG8_WAIT_V(6); PG8_BAR;
    }
    for (;;) {
        const bool has_next = S.next(ui + 1, nxt);
        const char* nA = has_next ? (const char*)g.A + (size_t)nxt.pm * tstep + nxt.kb : cA; const char* nB = has_next ? (const char*)g.Bt + (size_t)nxt.pn * tstep + nxt.kb : cB;
        for (int t = 0; t < nt; t += 2) {
            const bool last = (t == nt - 2);
            const char* a1 = cA + (size_t)(t + 1) * kstep;
            const char* a2 = last ? nA : cA + (size_t)(t + 2) * kstep; const char* b2 = last ? nB : cB + (size_t)(t + 2) * kstep;
            const char* a3 = a2 + kstep; const char* b3 = b2 + kstep;
            if (last && has_next) S.a_ready(nxt);
            if constexpr (SP2) {
            PG8_LDB(B0, 0, 0); PG8_LDB(B1, 0, 1); PG8_SCHED; PG8_LDA(At, 0, 0); PG8_STAGE(PG8_SA(1, 1), a1 + hstep, voffA);
            PG8_WAIT_V(8); PG8_WAIT_L(0); PG8_BAR; PG8_MMA(0, 0, At, B0); PG8_MMA(0, 1, At, B1); PG8_BAR; PG8_SCHED;
            PG8_LDA(At, 0, 1); PG8_STAGE(PG8_SB(0, 0), b2, voffB); PG8_STAGE(PG8_SB(0, 1), b2 + hstep, voffB); PG8_STAGE(PG8_SA(0, 0), a2, voffA);
            PG8_WAIT_V(8); PG8_WAIT_L(0); PG8_BAR; PG8_MMA(1, 0, At, B0); PG8_MMA(1, 1, At, B1); PG8_BAR; PG8_SCHED;
            PG8_LDB(B0, 1, 0); PG8_LDB(B1, 1, 1); PG8_SCHED; PG8_LDA(At, 1, 0); PG8_STAGE(PG8_SA(0, 1), a2 + hstep, voffA);
            PG8_WAIT_V(8); PG8_WAIT_L(0); PG8_BAR; PG8_MMA(0, 0, At, B0); PG8_MMA(0, 1, At, B1); PG8_BAR; PG8_SCHED;
            PG8_LDA(At, 1, 1); PG8_STAGE(PG8_SB(1, 0), b3, voffB); PG8_STAGE(PG8_SB(1, 1), b3 + hstep, voffB); PG8_STAGE(PG8_SA(1, 0), a3, voffA);
            PG8_WAIT_V(8); PG8_WAIT_L(0); PG8_BAR; PG8_MMA(1, 0, At, B0); PG8_MMA(1, 1, At, B1); PG8_BAR; PG8_SCHED;
            } else {
            PG8_LDB(B0, 0, 0); PG8_SCHED; PG8_LDA(At, 0, 0); PG8_STAGE(PG8_SA(1, 1), a1 + hstep, voffA);
            PG8_WAIT_L(8); PG8_BAR; PG8_WAIT_L(0); PG8_MMA(0, 0, At, B0); PG8_BAR; PG8_SCHED;
            PG8_LDB(B1, 0, 1); PG8_STAGE(PG8_SB(0, 0), b2, voffB);
            PG8_BAR; PG8_WAIT_L(0); PG8_MMA(0, 1, At, B1); PG8_BAR;
            PG8_LDA(At, 0, 1); PG8_STAGE(PG8_SA(0, 0), a2, voffA);
            PG8_BAR; PG8_WAIT_L(0); PG8_MMA(1, 0, At, B0); PG8_BAR; PG8_SCHED;
            PG8_STAGE(PG8_SB(0, 1), b2 + hstep, voffB);
            PG8_WAIT_V(6); PG8_BAR; PG8_MMA(1, 1, At, B1); PG8_BAR;
            PG8_LDB(B0, 1, 0); PG8_SCHED; PG8_LDA(At, 1, 0); PG8_STAGE(PG8_SA(0, 1), a2 + hstep, voffA);
            PG8_WAIT_L(8); PG8_BAR; PG8_WAIT_L(0); PG8_MMA(0, 0, At, B0); PG8_BAR; PG8_SCHED;
            PG8_LDB(B1, 1, 1); PG8_STAGE(PG8_SB(1, 0), b3, voffB);
            PG8_BAR; PG8_WAIT_L(0); PG8_MMA(0, 1, At, B1); PG8_BAR;
            PG8_LDA(At, 1, 1); PG8_STAGE(PG8_SA(1, 0), a3, voffA);
            PG8_BAR; PG8_WAIT_L(0); PG8_MMA(1, 0, At, B0); PG8_BAR; PG8_SCHED;
            PG8_STAGE(PG8_SB(1, 1), b3 + hstep, voffB);
            PG8_WAIT_V(6); PG8_BAR; PG8_MMA(1, 1, At, B1); PG8_BAR;
            }
        }
        if constexpr (ALIGN_EPI) { if (wr == 0) PG8_BAR; }
        bool keep_acc_ = false;
        if constexpr (Epi::MIDK) { keep_acc_ = (cur.kb == 0); if (keep_acc_) E.mid(acc, cur, wr, wc, fr, fq); else { E(acc, cur, wr, wc, fr, fq); S.done(cur); } }
        else if constexpr (!Epi::AFTER_DRAIN) { E(acc, cur, wr, wc, fr, fq); S.done(cur); }
        if (!has_next) break;
        if (!keep_acc_) {
#pragma unroll
        for (int a = 0; a < 2; ++a)
#pragma unroll
            for (int b = 0; b < 2; ++b)
#pragma unroll
                for (int m = 0; m < 4; ++m)
#pragma unroll
                    for (int n = 0; n < 2; ++n) acc[a][b][m][n] = (f32x4){0.f, 0.f, 0.f, 0.f};
        }
        cur = nxt; cA = nA; cB = nB; ++ui;
        if constexpr (ALIGN_EPI) { if (wr == 1) PG8_BAR; }
    }
    PG8_WAIT_V(0);
    if constexpr (!ALIGN_EPI) { if (wr == 0) PG8_BAR; }
    PG8_BAR;
    if constexpr (Epi::AFTER_DRAIN) { E.fused(acc, cur, wr, wc, fr, fq, lds, wid, lane); S.done(cur); }
#undef PG8_SA
#undef PG8_SB
#undef PG8_STAGE
#undef PG8_LDA
#undef PG8_LDB
#undef PG8_MMA
#undef PG8_WAIT_V
#undef PG8_WAIT_L
#undef PG8_BAR
#undef PG8_SCHED
}
}
namespace att {
constexpr int D = 128; constexpr float THR = 8.f; constexpr bool WSKIP = false;
constexpr float SCALE = 0.08838834764831845f;
constexpr int NW = 8, QBLK = 32, KVBLK = 64, QB = NW * QBLK;
constexpr int SHM_V = KVBLK * D * 2, SHM_K = KVBLK * D * 2;
constexpr int LDS_BYTES = 2 * SHM_V + 2 * SHM_K + NW * 64 * 4;

typedef short bf16x8 __attribute__((ext_vector_type(8)));
typedef short s16x4 __attribute__((ext_vector_type(4)));
typedef float f32x16 __attribute__((ext_vector_type(16)));
typedef float f32x4 __attribute__((ext_vector_type(4)));
typedef unsigned u32x4 __attribute__((ext_vector_type(4)));
template <class A, class Bt> struct same_t { static constexpr bool v = false; };
template <class A> struct same_t<A, A> { static constexpr bool v = true; };

#define KSWZ(row, colB) ((row) * 256 + ((colB) ^ (((row) & 7) << 4)))
#define SBAR() __builtin_amdgcn_sched_barrier(0)
__device__ __forceinline__ int v_st(int k, int c) { const int kk = (k & ~0xC) | ((k & 4) << 1) | ((k & 8) >> 1); return ((kk >> 3) * 4 + (c >> 5)) * 512 + ((kk & 7) * 32 + (c & 31)) * 2; }
__device__ __forceinline__ int v_rd_base(int lane) { return ((lane & 3) << 3) | (((lane >> 2) & 3) << 6) | (((lane >> 4) & 1) << 5) | (((lane >> 5) & 1) << 8); }
constexpr int v_rd_off(int d0, int ks, int half) { return d0 * 512 + ks * 4096 + half * 2048; }
__device__ __forceinline__ int crow(int r, int hi) { return (r & 3) + 8 * (r >> 2) + 4 * hi; }
__device__ __forceinline__ unsigned cvtpk(float lo, float hi) {
    unsigned r; asm volatile("v_cvt_pk_bf16_f32 %0, %1, %2" : "=v"(r) : "v"(lo), "v"(hi)); return r;
}
__device__ __forceinline__ bf16x8 pack8(f32x4 a, f32x4 b) {
    u32x4 w = {cvtpk(a[0], a[1]), cvtpk(a[2], a[3]), cvtpk(b[0], b[1]), cvtpk(b[2], b[3])};
    return *reinterpret_cast<bf16x8*>(&w);
}
template <class T> __device__ __forceinline__ bf16x8 load8(const T* p) {
    if constexpr (same_t<T, float>::v) { return pack8(*(const f32x4*)p, *(const f32x4*)(p + 4)); }
    else { return *reinterpret_cast<const bf16x8*>(p); }
}
__device__ __forceinline__ void mask_tile(f32x16& p0, f32x16& p1, int dq, unsigned W) {
    const float NEG = -__builtin_inff();
#pragma unroll
    for (int r = 0; r < 16; ++r) {
        const int c = (r & 3) + 8 * (r >> 2);
        if ((unsigned)(dq - c) >= W) p0[r] = NEG;
        if ((unsigned)(dq - c - 32) >= W) p1[r] = NEG;
    }
}
__device__ __forceinline__ void partialSM(f32x16& p0, f32x16& p1, float& m_reg, float& mn, float& alpha) {
    float pmax = p0[0]; for (int r = 1; r < 16; ++r) pmax = fmaxf(pmax, p0[r]); for (int r = 0; r < 16; ++r) pmax = fmaxf(pmax, p1[r]);
    { auto rr = __builtin_amdgcn_permlane32_swap(__float_as_uint(pmax), __float_as_uint(pmax), false, false);
      pmax = fmaxf(__uint_as_float(rr[0]), __uint_as_float(rr[1])); }
    constexpr float C2 = 1.4426950408889634f * SCALE;
    if (__builtin_expect(__all((pmax - m_reg) * SCALE <= THR), 1)) { mn = m_reg; alpha = 1.f; }
    else { mn = fmaxf(m_reg, pmax); alpha = __builtin_amdgcn_exp2f((m_reg - mn) * C2); m_reg = mn; }
    const float mnL = -mn * C2;
    for (int r = 0; r < 16; ++r) p0[r] = fmaf(p0[r], C2, mnL); for (int r = 0; r < 16; ++r) p1[r] = fmaf(p1[r], C2, mnL);
    for (int r = 0; r < 16; ++r) p0[r] = __builtin_amdgcn_exp2f(p0[r]);
}
__device__ __forceinline__ void finishSM(f32x16& p0, f32x16& p1, float alpha, float& l_reg, bf16x8& pa0, bf16x8& pa1, bf16x8& pa2, bf16x8& pa3) {
    for (int r = 0; r < 16; ++r) p1[r] = __builtin_amdgcn_exp2f(p1[r]);
    float ps = 0; for (int r = 0; r < 16; ++r) ps += p0[r]; for (int r = 0; r < 16; ++r) ps += p1[r];
    { auto rr = __builtin_amdgcn_permlane32_swap(__float_as_uint(ps), __float_as_uint(ps), false, false);
      ps = __uint_as_float(rr[0]) + __uint_as_float(rr[1]); }
    l_reg = l_reg * alpha + ps;
#define PK4(P, B_, OUT) do { unsigned a0 = cvtpk(P[B_+0], P[B_+1]), a1 = cvtpk(P[B_+2], P[B_+3]);                          \
        unsigned b0 = cvtpk(P[B_+4], P[B_+5]), b1 = cvtpk(P[B_+6], P[B_+7]);                                             \
        auto r0 = __builtin_amdgcn_permlane32_swap(a0, b0, false, false); auto r1 = __builtin_amdgcn_permlane32_swap(a1, b1, false, false); \
        u32x4 w = {r0[0], r1[0], r0[1], r1[1]}; OUT = *reinterpret_cast<bf16x8*>(&w); } while (0)
    PK4(p0, 0, pa0); PK4(p0, 8, pa1); PK4(p1, 0, pa2); PK4(p1, 8, pa3);
#undef PK4
}
template <int KB, bool SK>
__device__ __forceinline__ void qkt(f32x16& p0, f32x16& p1, const char* K_lds, int r32, int hi, const bf16x8* qr, bool act) {
    if (SK && !act) { const float NEG = -__builtin_inff();
#pragma unroll
        for (int r = 0; r < 16; ++r) { p0[r] = NEG; p1[r] = NEG; } return; }
    p0 = f32x16{}; p1 = f32x16{};
    const char* kb[4];
#pragma unroll
    for (int dd = 0; dd < 4; ++dd) kb[dd] = K_lds + KB * SHM_K + KSWZ(r32, (dd * 16 + hi * 8) * 2);
#pragma unroll
    for (int d0 = 0; d0 < 8; ++d0) { const char* a = kb[d0 & 3] + (d0 >> 2) * 128;
        bf16x8 b0 = *reinterpret_cast<const bf16x8*>(a);
        bf16x8 b1 = *reinterpret_cast<const bf16x8*>(a + 32 * 256);
        p0 = __builtin_amdgcn_mfma_f32_32x32x16_bf16(b0, qr[d0], p0, 0, 0, 0);
        p1 = __builtin_amdgcn_mfma_f32_32x32x16_bf16(b1, qr[d0], p1, 0, 0, 0); }
}
template <int VB, bool SK>
__device__ __forceinline__ void pv_tile(f32x16* o, int vb0, bf16x8 pa0, bf16x8 pa1, bf16x8 pa2, bf16x8 pa3, bool act) {
    if (SK && !act) return;
#define TRRD(dst, off) asm volatile("ds_read_b64_tr_b16 %0, %1 offset:%2" : "=&v"(dst) : "v"(vb0), "i"(off) : "memory")
#define PV_D0(d0) do { s16x4 l0, l1, l2, l3, h0, h1, h2, h3; constexpr int b_ = VB * SHM_V + v_rd_off(d0, 0, 0);     \
        TRRD(l0, b_); TRRD(h0, b_ + 2048); TRRD(l1, b_ + 4096); TRRD(h1, b_ + 6144); TRRD(l2, b_ + 8192); TRRD(h2, b_ + 10240); TRRD(l3, b_ + 12288); TRRD(h3, b_ + 14336); \
        asm volatile("s_waitcnt lgkmcnt(0)" ::: "memory"); SBAR();                 \
        o[d0] = __builtin_amdgcn_mfma_f32_32x32x16_bf16(pa0, (bf16x8){l0[0], l0[1], l0[2], l0[3], h0[0], h0[1], h0[2], h0[3]}, o[d0], 0, 0, 0);   \
        o[d0] = __builtin_amdgcn_mfma_f32_32x32x16_bf16(pa1, (bf16x8){l1[0], l1[1], l1[2], l1[3], h1[0], h1[1], h1[2], h1[3]}, o[d0], 0, 0, 0);   \
        o[d0] = __builtin_amdgcn_mfma_f32_32x32x16_bf16(pa2, (bf16x8){l2[0], l2[1], l2[2], l2[3], h2[0], h2[1], h2[2], h2[3]}, o[d0], 0, 0, 0);   \
        o[d0] = __builtin_amdgcn_mfma_f32_32x32x16_bf16(pa3, (bf16x8){l3[0], l3[1], l3[2], l3[3], h3[0], h3[1], h3[2], h3[3]}, o[d0], 0, 0, 0); } while (0)
    PV_D0(0); PV_D0(1); PV_D0(2); PV_D0(3);
#undef PV_D0
#undef TRRD
}
template <class TIn, class TOut> struct BlockRef { const TIn* Q; const TIn* K; const TIn* V; TOut* O; int P0; int ostride; int moba; const float* kmean; };
template <class TIn> struct Seam {
    bf16x8 qr[8];
    bf16x8 st_v0, st_v1, st_k0, st_k1; f32x4 sf0, sf1, sf2, sf3;
    f32x4 tq[16];
};
__device__ __forceinline__ int swa_jlo(int P0, int W) { const int lowk = P0 - W + 1; return lowk > 0 ? lowk / KVBLK : 0; }
#define ROW(p, k0, rr) ((p) + (size_t)((k0) + (rr)) * D + sc)
#define VMW() asm volatile("s_waitcnt vmcnt(0)" ::: "memory")
#define VMWN(n) asm volatile("s_waitcnt vmcnt(%0)" :: "i"(n) : "memory")
#define SLOAD_H(Kp, Vp, k0) do { S.st_v0 = load8<TIn>(ROW(Vp, k0, sr)); S.st_v1 = load8<TIn>(ROW(Vp, k0, 32 + sr));              \
                         S.st_k0 = load8<TIn>(ROW(Kp, k0, sr)); S.st_k1 = load8<TIn>(ROW(Kp, k0, 32 + sr)); } while (0)
#define SWRITE_HK(bf) do { *(bf16x8*)(K_lds + (bf) * SHM_K + kws) = S.st_k0; *(bf16x8*)(K_lds + (bf) * SHM_K + kws + 32 * 256) = S.st_k1; } while (0)
#define SWRITE_HV(bf) do { *(bf16x8*)(V_lds + (bf) * SHM_V + vst0) = S.st_v0; *(bf16x8*)(V_lds + (bf) * SHM_V + vst1) = S.st_v1; } while (0)
#define SWRITE_H(bf) do { SWRITE_HV(bf); SWRITE_HK(bf); } while (0)
#define SLOAD_F(p, k0) do { S.sf0 = *(const f32x4*)ROW(p, k0, sr); S.sf1 = *(const f32x4*)(ROW(p, k0, sr) + 4);                \
                            S.sf2 = *(const f32x4*)ROW(p, k0, 32 + sr); S.sf3 = *(const f32x4*)(ROW(p, k0, 32 + sr) + 4); } while (0)
#define SWRITE_KF(bf) do { *(bf16x8*)(K_lds + (bf) * SHM_K + kws) = pack8(S.sf0, S.sf1); *(bf16x8*)(K_lds + (bf) * SHM_K + kws + 32 * 256) = pack8(S.sf2, S.sf3); } while (0)
#define SWRITE_VF(bf) do { *(bf16x8*)(V_lds + (bf) * SHM_V + vst0) = pack8(S.sf0, S.sf1); *(bf16x8*)(V_lds + (bf) * SHM_V + vst1) = pack8(S.sf2, S.sf3); } while (0)
template <class TIn, class TOut>
__device__ __forceinline__ void causal_swa_prime(const BlockRef<TIn, TOut>& cur, int W, char* lds, Seam<TIn>& S, const int wave_s__) {
    constexpr bool F32 = same_t<TIn, float>::v;
    const int tid = opq_tid(wave_s__), wid = __builtin_amdgcn_readfirstlane(tid >> 6), lane = tid & 63, r32 = lane & 31, hi = lane >> 5;
    const int sr = tid >> 4, sc = (tid & 15) * 8, kws = KSWZ(sr, sc * 2); char* K_lds = lds + 2 * SHM_V;
    const int kb0 = swa_jlo(cur.P0, W) * KVBLK;
    for (int d0 = 0; d0 < 8; ++d0) S.qr[d0] = load8<TIn>(cur.Q + (size_t)(wid * QBLK + r32) * D + d0 * 16 + hi * 8);
    if constexpr (F32) { SLOAD_F((const float*)cur.K, kb0); VMW(); SWRITE_KF(0); SBAR(); SLOAD_F((const float*)cur.V, kb0); }
    else { SLOAD_H(cur.K, cur.V, kb0); VMW(); SWRITE_HK(0); }
    __syncthreads();
}
template <class TIn, class TOut>
__device__ __forceinline__ void causal_swa_block(const BlockRef<TIn, TOut>& cur, const BlockRef<TIn, TOut>& nxt, int skv, int W, char* lds, Seam<TIn>& S, const int wave_s__) {
    constexpr bool F32 = same_t<TIn, float>::v;
    const int tid = opq_tid(wave_s__), wid = __builtin_amdgcn_readfirstlane(tid >> 6), lane = tid & 63, r32 = lane & 31, hi = lane >> 5;
    const int j_lo = swa_jlo(cur.P0, W);
    int j_hi = (cur.P0 + QB - 1) / KVBLK + 1; if (j_hi > skv / KVBLK) j_hi = skv / KVBLK;
    const int NT = j_hi - j_lo;
    const int kbn = swa_jlo(nxt.P0, W) * KVBLK;
    const int qlo = cur.P0 + wid * QBLK, qm = qlo + r32 - 4 * hi;
    char* V_lds = lds; char* K_lds = lds + 2 * SHM_V;
    float* ws = (float*)(lds + 2 * SHM_V + 2 * SHM_K) + wid * 64; float* li_l = ws, * al_l = ws + 32;
    float m_reg = -1e30f, l_reg = 0; f32x16 o[4] = {};
    const int sr = tid >> 4, sc = (tid & 15) * 8, vst0 = v_st(sr, sc), vst1 = v_st(32 + sr, sc), kws = KSWZ(sr, sc * 2);
    const int vb0 = (int)(uintptr_t)V_lds + v_rd_base(lane);
    const TIn* Kh = cur.K; const TIn* Vh = cur.V;
    const int own = cur.P0 >> 8; const int moba = cur.moba;
    unsigned selmask = 0xFFFFFFFFu;
    if (moba) {
        float qf[64];
#pragma unroll
        for (int d0 = 0; d0 < 8; ++d0)
#pragma unroll
            for (int j = 0; j < 8; ++j) qf[d0 * 8 + j] = __uint_as_float(((unsigned)(unsigned short)S.qr[d0][j]) << 16);
        float g1 = -3e38f, g2 = -3e38f, g3 = -3e38f; int i1 = -1, i2 = -1, i3 = -1;
        for (int n = 0; n < own; ++n) {
            const float* km = cur.kmean + n * 128 + hi * 8;
            float a0 = 0.f, a1 = 0.f;
#pragma unroll
            for (int d0 = 0; d0 < 8; ++d0) { const f32x4 k0 = *(const f32x4*)(km + d0 * 16), k1 = *(const f32x4*)(km + d0 * 16 + 4);
                a0 = fmaf(qf[d0 * 8 + 0], k0[0], a0); a0 = fmaf(qf[d0 * 8 + 1], k0[1], a0); a0 = fmaf(qf[d0 * 8 + 2], k0[2], a0); a0 = fmaf(qf[d0 * 8 + 3], k0[3], a0);
                a1 = fmaf(qf[d0 * 8 + 4], k1[0], a1); a1 = fmaf(qf[d0 * 8 + 5], k1[1], a1); a1 = fmaf(qf[d0 * 8 + 6], k1[2], a1); a1 = fmaf(qf[d0 * 8 + 7], k1[3], a1); }
            float a = a0 + a1; a += __shfl_xor(a, 32);
            const bool b1 = a > g1, b2 = a > g2, b3 = a > g3;
            g3 = b2 ? g2 : (b3 ? a : g3); i3 = b2 ? i2 : (b3 ? n : i3);
            g2 = b1 ? g1 : (b2 ? a : g2); i2 = b1 ? i1 : (b2 ? n : i2);
            g1 = b1 ? a : g1; i1 = b1 ? n : i1;
        }
        selmask = 0u; if (i1 >= 0) selmask |= 1u << i1; if (i2 >= 0) selmask |= 1u << i2; if (i3 >= 0) selmask |= 1u << i3;
    }
#define RESC(a) do { if (__any((a) < 1.f)) { if (hi == 0) al_l[r32] = (a); asm volatile("s_waitcnt lgkmcnt(0)" ::: "memory");              \
                     for (int d_ = 0; d_ < 4; ++d_) for (int r = 0; r < 16; ++r) o[d_][r] *= al_l[crow(r, hi)]; } } while (0)
#define KBASE(t) ((j_lo + (t)) * KVBLK)
#define ACT(t) (KBASE(t) <= qlo + QBLK - 1 && KBASE(t) + KVBLK - 1 >= qlo - W + 1)
#define MASKT(P0_, P1_, t) do { const int kb_ = KBASE(t); if ((!SK || ACT(t)) && (kb_ + KVBLK - 1 > qlo || kb_ <= qlo + QBLK - 1 - W)) mask_tile(P0_, P1_, qm - kb_, (unsigned)W); \
        if (moba && (kb_ >> 8) < own) { const bool keep_ = (selmask >> (kb_ >> 8)) & 1u; const float NEG_ = -__builtin_inff(); \
            _Pragma("unroll") for (int r_ = 0; r_ < 16; ++r_) { P0_[r_] = keep_ ? P0_[r_] : NEG_; P1_[r_] = keep_ ? P1_[r_] : NEG_; } } } while (0)
    constexpr int NQL = F32 ? 16 : 8;
    constexpr bool SK = WSKIP && !F32;
#define SEAM_K0() do { VMWN(NQL); if constexpr (F32) { SWRITE_KF(0); SBAR(); SLOAD_F((const float*)nxt.V, kbn); } else { SWRITE_HK(0); } SBAR(); } while (0)
    f32x16 pA0, pA1, pB0, pB1; float mnA, mnB, alA, alB; bf16x8 pa0, pa1, pa2, pa3;
    if constexpr (F32) { VMW(); SWRITE_VF(0); SBAR(); } else { SWRITE_HV(0); SBAR(); }
    if (NT > 1) { if constexpr (F32) SLOAD_F((const float*)Kh, KBASE(1)); else SLOAD_H(Kh, Vh, KBASE(1)); }
    SBAR(); qkt<0, SK>(pA0, pA1, K_lds, r32, hi, S.qr, ACT(0));
    if constexpr (F32) { if (NT > 1) { VMW(); SWRITE_KF(1); SBAR(); SLOAD_F((const float*)Vh, KBASE(1)); } }
    MASKT(pA0, pA1, 0); partialSM(pA0, pA1, m_reg, mnA, alA);
    if (NT > 1) { VMW(); if constexpr (F32) { SWRITE_VF(1); SBAR(); if (NT > 2) SLOAD_F((const float*)Kh, KBASE(2)); } else SWRITE_H(1); }
    __syncthreads();
#define HALF_STEP(PX0, PX1, mnX, alX, PY0, PY1, alY, t, KB, VB, SB) do {                                                      \
        SBAR(); qkt<KB, SK>(PX0, PX1, K_lds, r32, hi, S.qr, ACT(t));                                             \
        finishSM(PY0, PY1, alY, l_reg, pa0, pa1, pa2, pa3); SBAR();                                                           \
        if ((t) + 1 < NT) { if constexpr (F32) { VMW(); SWRITE_KF(SB); SBAR(); SLOAD_F((const float*)Vh, KBASE((t) + 1)); }  \
                            else { SLOAD_H(Kh, Vh, KBASE((t) + 1)); } SBAR(); }                                               \
        pv_tile<VB, SK>(o, vb0, pa0, pa1, pa2, pa3, ACT((t) - 1)); MASKT(PX0, PX1, (t)); partialSM(PX0, PX1, m_reg, mnX, alX);                                        \
        __syncthreads();                                                                                                      \
        if ((t) + 1 < NT) { VMW(); if constexpr (F32) { SWRITE_VF(SB); SBAR(); if ((t) + 2 < NT) SLOAD_F((const float*)Kh, KBASE((t) + 2)); } \
                            else { SWRITE_H(SB); } }                                                                          \
        RESC(alX); __syncthreads(); } while (0)
    for (int t = 1; t + 1 < NT; t += 2) {
        HALF_STEP(pB0, pB1, mnB, alB, pA0, pA1, alA, t, 1, 0, 0);
        HALF_STEP(pA0, pA1, mnA, alA, pB0, pB1, alB, t + 1, 0, 1, 1);
    }
    const bool even = (NT & 1) == 0;
    if (even) { SBAR(); qkt<1, SK>(pB0, pB1, K_lds, r32, hi, S.qr, ACT(NT - 1)); SBAR(); }
#define QROW(e) (nxt.Q + (size_t)(wid * QBLK + r32) * D + ((e) >> 1) * 16 + hi * 8 + ((e) & 1) * 4)
    if constexpr (F32) { SLOAD_F((const float*)nxt.K, kbn); SBAR();
#pragma unroll
        for (int e = 0; e < 8; ++e) S.tq[e] = *(const f32x4*)QROW(e); }
    else { SLOAD_H(nxt.K, nxt.V, kbn); SBAR();
#pragma unroll
        for (int d0 = 0; d0 < 8; ++d0) S.qr[d0] = load8<TIn>(nxt.Q + (size_t)(wid * QBLK + r32) * D + d0 * 16 + hi * 8); }
    SBAR();
    finishSM(pA0, pA1, alA, l_reg, pa0, pa1, pa2, pa3); SBAR();
    if constexpr (F32) {
#pragma unroll
        for (int e = 8; e < 16; ++e) S.tq[e] = *(const f32x4*)QROW(e); SBAR(); }
#undef QROW
    pv_tile<0, SK>(o, vb0, pa0, pa1, pa2, pa3, ACT(even ? NT - 2 : NT - 1));
    if (even) { MASKT(pB0, pB1, NT - 1); partialSM(pB0, pB1, m_reg, mnB, alB); __syncthreads(); RESC(alB);
        finishSM(pB0, pB1, alB, l_reg, pa0, pa1, pa2, pa3); SBAR(); pv_tile<1, SK>(o, vb0, pa0, pa1, pa2, pa3, ACT(NT - 1)); }
    SBAR(); SEAM_K0();
    if (hi == 0) li_l[r32] = l_reg; asm volatile("s_waitcnt lgkmcnt(0)" ::: "memory");
    float rli[16];
#pragma unroll
    for (int r = 0; r < 16; ++r) rli[r] = __builtin_amdgcn_rcpf(li_l[crow(r, hi)]);
    const int ostr = cur.ostride; TOut* Ow = cur.O + (size_t)(wid * QBLK) * ostr;
#pragma unroll
    for (int r = 0; r < 16; ++r) { const int orow = crow(r, hi);
#pragma unroll
        for (int d0 = 0; d0 < 4; ++d0) { const float v = o[d0][r] * rli[r];
            if constexpr (same_t<TOut, float>::v) { Ow[(size_t)orow * ostr + d0 * 32 + r32] = v; }
            else { const float vn = __shfl_xor(v, 1);
                   if ((r32 & 1) == 0) *(unsigned*)(Ow + (size_t)orow * ostr + d0 * 32 + r32) = cvtpk(v, vn); } } }
    if constexpr (F32) {
#pragma unroll
        for (int d0 = 0; d0 < 8; ++d0) S.qr[d0] = pack8(S.tq[2 * d0], S.tq[2 * d0 + 1]); }
    __syncthreads();
#undef RESC
#undef KBASE
#undef ACT
#undef MASKT
#undef SEAM_K0
#undef HALF_STEP
}
#undef ROW
#undef VMW
#undef VMWN
#undef SLOAD_H
#undef SWRITE_HK
#undef SWRITE_HV
#undef SWRITE_H
#undef SLOAD_F
#undef SWRITE_KF
#undef SWRITE_VF

}
#define GAS __attribute__((address_space(1)))
#define LAS __attribute__((address_space(3)))
typedef unsigned short bf16;
typedef unsigned v4u __attribute__((ext_vector_type(4)));
typedef float f32x4 __attribute__((ext_vector_type(4)));
typedef short bf16x8 __attribute__((ext_vector_type(8)));
typedef GAS unsigned gu32;
typedef GAS unsigned long long gu64;
#define RLX_AGENT __ATOMIC_RELAXED, __HIP_MEMORY_SCOPE_AGENT
#define LDS_WAIT() asm volatile("s_waitcnt lgkmcnt(0)" ::: "memory")
#define VM_WAIT() asm volatile("s_waitcnt vmcnt(0)" ::: "memory")
__device__ __forceinline__ unsigned long long rt() { return __builtin_amdgcn_s_memrealtime(); }
__device__ __forceinline__ unsigned f2bf(float f) { unsigned u = __builtin_bit_cast(unsigned, f); return (u + 0x7fffu + ((u >> 16) & 1u)) >> 16; }
__device__ __forceinline__ unsigned pk2(float lo, float hi) { return f2bf(lo) | (f2bf(hi) << 16); }

#define XB_TMO      128
#define XB_XCNT(j)  (256  + 64 * (j))
#define XB_XSUB(j)  (1280 + 64 * (j))
#define XB_XGEN(j)  (2304 + 64 * (j))
#define XB_TOP      3328
#define XB_TOPGEN   3392
#define XCD_BAR_WORDS 3456
#define XB_SPIN_CAP (1u << 18)

__device__ __forceinline__ unsigned xb_ld(unsigned* p)              { return __hip_atomic_load(p, __ATOMIC_RELAXED, __HIP_MEMORY_SCOPE_AGENT); }
__device__ __forceinline__ unsigned xb_add(unsigned* p, unsigned v) { return __hip_atomic_fetch_add(p, v, __ATOMIC_RELAXED, __HIP_MEMORY_SCOPE_AGENT); }
__device__ __forceinline__ unsigned xb_xcc_id() { return (unsigned)__builtin_amdgcn_s_getreg((3 << 11) | 20) & 0xFu; }
#define XB_SPIN(cond, bar) do { unsigned _sp = 0; while (cond) { __builtin_amdgcn_s_sleep(1); \
    if ((++_sp & 255u) == 0u) { if (xb_ld(&(bar)[XB_TMO])) break; if (_sp > XB_SPIN_CAP) { atomicAdd(&(bar)[XB_TMO], 1u); break; } } } } while (0)

struct XcdBarrier {
    unsigned* bar; unsigned x; bool lead;
    volatile LAS unsigned* st;
};

__device__ __forceinline__ XcdBarrier xcd_barrier_post(unsigned* bar, volatile LAS unsigned* st) {
    XcdBarrier b; b.bar = bar; b.x = xb_xcc_id(); b.st = st;
    if (threadIdx.x == 0) (void)xb_add(&bar[XB_XCNT(b.x)], 1u);
    return b;
}
__device__ __forceinline__ void xcd_barrier_complete(unsigned* bar, unsigned x, unsigned& nloc, unsigned& nx) {
    const unsigned G = gridDim.x * gridDim.y * gridDim.z;
    unsigned sum, cnt, mine, sp = 0u;
    for (;;) {
        sum = 0u; cnt = 0u; mine = 0u;
#pragma unroll
        for (unsigned j = 0; j < 16; ++j) { const unsigned c = xb_ld(&bar[XB_XCNT(j)]); sum += c; cnt += (c > 0u) ? 1u : 0u; mine = (j == x) ? c : mine; }
        if (sum == G) break;
        __builtin_amdgcn_s_sleep(1);
        if ((++sp & 255u) == 0u) { if (xb_ld(&bar[XB_TMO])) break; if (sp > XB_SPIN_CAP) { atomicAdd(&bar[XB_TMO], 1u); break; } }
    }
    nloc = mine > 0u ? mine : 1u; nx = cnt > 0u ? cnt : 1u;
}

__device__ __forceinline__ void xcd_barrier(const XcdBarrier& b) {
    asm volatile("s_waitcnt vmcnt(0)" ::: "memory");
    __syncthreads();
    if (b.lead) {
        unsigned* bar = b.bar;
        __builtin_amdgcn_s_waitcnt(0);
        unsigned nloc = b.st[0], nx = b.st[1];
        if (nloc == 0u) { xcd_barrier_complete(bar, b.x, nloc, nx); b.st[0] = nloc; b.st[1] = nx; }
        const unsigned old = xb_add(&bar[XB_XSUB(b.x)], 1u);
        const unsigned gen = old / nloc;
        if (old + 1u == (gen + 1u) * nloc) {
            __builtin_amdgcn_fence(__ATOMIC_RELEASE, "agent");
            asm volatile("s_waitcnt vmcnt(0)" ::: "memory");
            const unsigned og = xb_add(&bar[XB_TOP], 1u);
            const unsigned tg = og / nx;
            if (og + 1u == (tg + 1u) * nx) xb_add(&bar[XB_TOPGEN], 1u);
            else XB_SPIN(xb_ld(&bar[XB_TOPGEN]) == tg, bar);
            __builtin_amdgcn_fence(__ATOMIC_ACQUIRE, "agent");
            xb_add(&bar[XB_XGEN(b.x)], 1u);
            asm volatile("s_waitcnt vmcnt(0)" ::: "memory");
        } else {
            XB_SPIN(xb_ld(&bar[XB_XGEN(b.x)]) == gen, bar);
            __builtin_amdgcn_fence(__ATOMIC_ACQUIRE, "agent");
            asm volatile("s_waitcnt vmcnt(0)" ::: "memory");
        }
    }
    __syncthreads();
}

constexpr int NWAVES = 8;
constexpr int BATCH = 2, SEQ = 4096, T = BATCH * SEQ, DM = 2048, DEPTH = 2;
constexpr int IN_COLS = 10240, NEXP = 16384;
constexpr float LN_EPS = 1e-5f, RMS_EPS = 1e-5f;
constexpr float DN_ALPHA = 1.4142135623730951f;

constexpr size_t MiB = 1u << 20;
constexpr size_t WS_CTL = 0, CTL_ZERO_BYTES = 1 * MiB;
constexpr size_t WS_ROPE = 1 * MiB;
constexpr size_t WS_KMEAN = 1 * MiB + 512 * 1024;
constexpr size_t WS_SUBK = 2 * MiB;
constexpr size_t WS_WIN = 4 * MiB;
constexpr size_t WS_WBR = 84 * MiB;
constexpr size_t WS_WOUT = 100 * MiB, WS_WQ = 116 * MiB;
constexpr size_t WS_PU8 = 132 * MiB, WS_PV8 = 132 * MiB + (size_t)2 * 16384 * 1536;
constexpr size_t WS_RSP = 230 * MiB;
constexpr size_t WS_C1P = 236 * MiB, WS_C2P = 237 * MiB;
constexpr size_t WS_SCL = 260 * MiB;
constexpr size_t WS_QKV = 388 * MiB;
constexpr size_t WS_GATES = 484 * MiB;
constexpr size_t WS_YMD = 548 * MiB;
constexpr size_t WS_QP = 548 * MiB;
constexpr size_t WS_OD = 580 * MiB;
constexpr size_t WS_X1 = 580 * MiB;
constexpr size_t WS_MF = 644 * MiB;
constexpr size_t WS_MB = 708 * MiB;
constexpr size_t WS_X1B = 740 * MiB;
constexpr size_t WS_IDX = 772 * MiB, WS_GATE = 776 * MiB;
constexpr size_t WS_X2 = 780 * MiB;
constexpr size_t WS_XB = 844 * MiB;
constexpr size_t WS_END = 876 * MiB;

constexpr int CW_ATTQ = 64;
constexpr int CW_BAR = 4096;


constexpr int RING_OFF = 0, RING_BYTES = 131072;
constexpr int PEER_TC_OFF = RING_BYTES;
constexpr int LDSCTL_OFF = RING_BYTES + 16384, MISC_OFF = LDSCTL_OFF + 320;
constexpr int PEER_TC16_OFF = LDSCTL_OFF + 4096;
constexpr int LDS_BYTES = PEER_TC16_OFF + 8192;

struct Frame {
    LAS unsigned char* lds;
    volatile LAS unsigned* MISC;
    gu32* ctl;
    unsigned char* ws;
    int tid, lane, wave;
    int vcu, G;
    const float* in[15];
    float* out;
};
extern __shared__ __attribute__((aligned(16))) unsigned char lds_all[];
constexpr int CTX_OFF = MISC_OFF + 128;
__device__ __forceinline__ unsigned long long ctx_ld(int i) {
    volatile LAS unsigned* p = (volatile LAS unsigned*)((LAS unsigned char*)lds_all + CTX_OFF + 8 * i);
    const unsigned lo = __builtin_amdgcn_readfirstlane(p[0]), hi = __builtin_amdgcn_readfirstlane(p[1]);
    return ((unsigned long long)hi << 32) | lo;
}
__device__ __forceinline__ void mk_frame(Frame& F, const int wave_s__) {
    F.lds = (LAS unsigned char*)lds_all;
    F.MISC = (volatile LAS unsigned*)(F.lds + MISC_OFF);
    F.tid = opq_tid(wave_s__); F.lane = F.tid & 63; F.wave = __builtin_amdgcn_readfirstlane(F.tid >> 6);
    F.G = gridDim.x; { const int bx = blockIdx.x; F.vcu = (F.G % 8 == 0) ? (bx % 8) * (F.G / 8) + bx / 8 : bx; }
#pragma unroll
    for (int i = 0; i < 15; ++i) F.in[i] = (const float*)ctx_ld(i);
    F.out = (float*)ctx_ld(15); F.ws = (unsigned char*)ctx_ld(16); F.ctl = (gu32*)(F.ws + WS_CTL);
}
__device__ __forceinline__ float wave_sum(float v) {
#pragma unroll
    for (int o = 1; o < 64; o <<= 1) v += __shfl_xor(v, o);
    return v;
}
__device__ __forceinline__ float bf2f(unsigned short h) { return __uint_as_float(((unsigned)h) << 16); }
__device__ __forceinline__ float bflo(unsigned w) { return __uint_as_float(w << 16); }
__device__ __forceinline__ float bfhi(unsigned w) { return __uint_as_float(w & 0xffff0000u); }

__device__ __forceinline__ void p0_transpose_item(const float* W, int K, int N, bf16* WT, int ldk, int koff, LAS float* scr, int item, int lane) {
    const int nblk = N / 32, kb = item / nblk, nb = item % nblk, k0 = 64 * kb, n0 = 32 * nb;
    float tv[32];
#pragma unroll
    for (int i = 0; i < 32; ++i) { const int kk = 2 * i + (lane >> 5); tv[i] = __builtin_nontemporal_load((const GAS float*)&W[(size_t)(k0 + kk) * N + n0 + (lane & 31)]); }
#pragma unroll
    for (int i = 0; i < 32; ++i) { const int kk = 2 * i + (lane >> 5); scr[kk * 33 + (lane & 31)] = tv[i]; }
    LDS_WAIT(); asm volatile("" ::: "memory");
    const int c = lane & 7;
#pragma unroll
    for (int j = 0; j < 4; ++j) { const int n = (lane >> 3) + 8 * j; const LAS float* s = scr + (8 * c) * 33 + n;
        v4u o; o.x = pk2(s[0 * 33], s[1 * 33]); o.y = pk2(s[2 * 33], s[3 * 33]); o.z = pk2(s[4 * 33], s[5 * 33]); o.w = pk2(s[6 * 33], s[7 * 33]);
        *(GAS v4u*)(WT + (size_t)(n0 + n) * ldk + koff + k0 + 8 * c) = o; }
    LDS_WAIT(); asm volatile("" ::: "memory");
}
__device__ __forceinline__ void p0_transpose_wq_item(const float* W, const float* g, const float* b, bf16* WT, float* c1, float* c2, LAS float* scr, int item, int lane) {
    constexpr int K = DM, N = DM;
    const int nblk = N / 32, kb = item / nblk, nb = item % nblk, k0 = 64 * kb, n0 = 32 * nb;
    float tv[32]; float p1 = 0.f, p2 = 0.f;
#pragma unroll
    for (int i = 0; i < 32; ++i) { const int kk = 2 * i + (lane >> 5); tv[i] = __builtin_nontemporal_load((const GAS float*)&W[(size_t)(k0 + kk) * N + n0 + (lane & 31)]); }
#pragma unroll
    for (int i = 0; i < 32; ++i) { const int kk = 2 * i + (lane >> 5); const float gw = tv[i] * g[k0 + kk];
        p1 += __uint_as_float(f2bf(gw) << 16); p2 = fmaf(tv[i], b[k0 + kk], p2); scr[kk * 33 + (lane & 31)] = gw; }
    p1 += __shfl_xor(p1, 32); p2 += __shfl_xor(p2, 32);
    if (lane < 32) { c1[(size_t)kb * N + n0 + lane] = p1; c2[(size_t)kb * N + n0 + lane] = p2; }
    LDS_WAIT(); asm volatile("" ::: "memory");
    const int c = lane & 7;
#pragma unroll
    for (int j = 0; j < 4; ++j) { const int n = (lane >> 3) + 8 * j; const LAS float* s = scr + (8 * c) * 33 + n;
        v4u o; o.x = pk2(s[0 * 33], s[1 * 33]); o.y = pk2(s[2 * 33], s[3 * 33]); o.z = pk2(s[4 * 33], s[5 * 33]); o.w = pk2(s[6 * 33], s[7 * 33]);
        *(GAS v4u*)(WT + (size_t)(n0 + n) * K + k0 + 8 * c) = o; }
    LDS_WAIT(); asm volatile("" ::: "memory");
}
__device__ __forceinline__ void convert_rows(const float* src, bf16* dst, size_t n8, size_t gtid, size_t nthr) {
    for (size_t i = gtid; i < n8; i += 4 * nthr) {
        f32x4 a[4], b[4];
#pragma unroll
        for (int u = 0; u < 4; ++u) { const size_t k = i + u * nthr; if (k < n8) { a[u] = __builtin_nontemporal_load((const GAS f32x4*)(src + k * 8)); b[u] = __builtin_nontemporal_load((const GAS f32x4*)(src + k * 8 + 4)); } }
#pragma unroll
        for (int u = 0; u < 4; ++u) { const size_t k = i + u * nthr; if (k < n8) { v4u o; o.x = pk2(a[u][0], a[u][1]); o.y = pk2(a[u][2], a[u][3]); o.z = pk2(b[u][0], b[u][1]); o.w = pk2(b[u][2], b[u][3]);
            *(GAS v4u*)(dst + k * 8) = o; } }
    }
}
constexpr int ROW6 = 1536;
typedef float f32x16 __attribute__((ext_vector_type(16)));
typedef unsigned u32x6 __attribute__((ext_vector_type(6)));
typedef unsigned u32x3 __attribute__((ext_vector_type(3)));
constexpr int FP6_CUS = 64;
__device__ __forceinline__ void convert_fp6_layer(Frame& F, int l, int cw, int nw) {
    unsigned char* P6 = F.ws + WS_PU8; float* SCL = (float*)(F.ws + WS_SCL);
    const int j = F.lane & 15, g = F.lane >> 4;
    for (int i0 = cw; i0 < 2 * NEXP; i0 += 4 * nw) {
        f32x4 v[4][8];
#pragma unroll
        for (int rr = 0; rr < 4; ++rr) { const int i = min(i0 + rr * nw, 2 * NEXP - 1); const int row = (i < NEXP) ? (l * NEXP + i) : ((2 + l) * NEXP + i - NEXP);
            const float* src = ((row >> 15) ? F.in[12] : F.in[11]) + (size_t)(row & (2 * NEXP - 1)) * DM;
#pragma unroll
            for (int ii = 0; ii < 8; ++ii) v[rr][ii] = __builtin_nontemporal_load((const GAS f32x4*)(src + (j + 16 * (8 * g + ii)) * 4)); }
        asm volatile("" : "+v"(v[0][0]), "+v"(v[0][1]), "+v"(v[0][2]), "+v"(v[0][3]), "+v"(v[0][4]), "+v"(v[0][5]), "+v"(v[0][6]), "+v"(v[0][7]),
                          "+v"(v[1][0]), "+v"(v[1][1]), "+v"(v[1][2]), "+v"(v[1][3]), "+v"(v[1][4]), "+v"(v[1][5]), "+v"(v[1][6]), "+v"(v[1][7]),
                          "+v"(v[2][0]), "+v"(v[2][1]), "+v"(v[2][2]), "+v"(v[2][3]), "+v"(v[2][4]), "+v"(v[2][5]), "+v"(v[2][6]), "+v"(v[2][7]));
        asm volatile("" : "+v"(v[3][0]), "+v"(v[3][1]), "+v"(v[3][2]), "+v"(v[3][3]), "+v"(v[3][4]), "+v"(v[3][5]), "+v"(v[3][6]), "+v"(v[3][7]));
#pragma unroll
        for (int rr = 0; rr < 4; ++rr) { const int i = i0 + rr * nw; if (i < 2 * NEXP) { const int row = (i < NEXP) ? (l * NEXP + i) : ((2 + l) * NEXP + i - NEXP);
            float m = 0.f;
#pragma unroll
            for (int ii = 0; ii < 8; ++ii) m = fmaxf(m, fmaxf(fmaxf(fabsf(v[rr][ii][0]), fabsf(v[rr][ii][1])), fmaxf(fabsf(v[rr][ii][2]), fabsf(v[rr][ii][3]))));
#pragma unroll
            for (int o = 1; o < 64; o <<= 1) m = fmaxf(m, __shfl_xor(m, o));
            const float sc = m > 0.f ? 7.5f / m : 1.0f, inv = m > 0.f ? m * (1.0f / 7.5f) : 1.0f;
            typedef _Float16 h32_t __attribute__((ext_vector_type(32)));
            h32_t hv;
#pragma unroll
            for (int ii = 0; ii < 8; ++ii)
#pragma unroll
                for (int c = 0; c < 4; ++c) hv[4 * ii + c] = (_Float16)(v[rr][ii][c] * sc);
            const u32x6 p = __builtin_amdgcn_cvt_scalef32_pk32_fp6_f16(hv, 1.0f);
            unsigned char* dst = P6 + (size_t)row * ROW6 + j * 16;
#pragma unroll
            for (int u = 0; u < 6; u += 2) { const int D = 6 * g + u;
                __builtin_nontemporal_store((unsigned long long)p[u] | ((unsigned long long)p[u + 1] << 32), (GAS unsigned long long*)(dst + 256 * (D >> 2) + 4 * (D & 3))); }
            if (F.lane == 0) SCL[row] = inv; } }
    }
}
__device__ __forceinline__ void p0_prologue(Frame& F) {
    LAS float* scr = (LAS float*)(F.lds + RING_OFF + F.wave * 16384);
    const int gw = F.vcu * NWAVES + F.wave, NGW = F.G * NWAVES;
    constexpr int I_IN = (DM / 64) * (IN_COLS / 32), I_BR = (1024 / 64) * (DM / 32), I_SQ = (DM / 64) * (DM / 32);
    constexpr int I_LAYER = I_IN + 2 * I_BR + 2 * I_SQ, NITEMS = DEPTH * I_LAYER;
    for (int it = gw; it < NITEMS; it += NGW) {
        const int l = it / I_LAYER; int r = it % I_LAYER;
        if (r < I_IN) { p0_transpose_item(F.in[1] + (size_t)l * DM * IN_COLS, DM, IN_COLS, (bf16*)(F.ws + WS_WIN) + (size_t)l * IN_COLS * DM, DM, 0, scr, r, F.lane); continue; } r -= I_IN;
        if (r < I_BR) { p0_transpose_item(F.in[2] + (size_t)l * 1024 * DM, 1024, DM, (bf16*)(F.ws + WS_WBR) + (size_t)l * DM * DM, DM, 0, scr, r, F.lane); continue; } r -= I_BR;
        if (r < I_BR) { p0_transpose_item(F.in[3] + (size_t)l * 1024 * DM, 1024, DM, (bf16*)(F.ws + WS_WBR) + (size_t)l * DM * DM, DM, 1024, scr, r, F.lane); continue; } r -= I_BR;
        if (r < I_SQ) { p0_transpose_item(F.in[4] + (size_t)l * DM * DM, DM, DM, (bf16*)(F.ws + WS_WOUT) + (size_t)l * DM * DM, DM, 0, scr, r, F.lane); continue; } r -= I_SQ;
        p0_transpose_wq_item(F.in[9] + (size_t)l * DM * DM, F.in[7] + (size_t)l * DM, F.in[8] + (size_t)l * DM, (bf16*)(F.ws + WS_WQ) + (size_t)l * DM * DM,
                             (float*)(F.ws + WS_C1P) + (size_t)l * 32 * DM, (float*)(F.ws + WS_C2P) + (size_t)l * 32 * DM, scr, r, F.lane);
    }
    const size_t gtid = (size_t)F.vcu * (NWAVES * 64) + F.tid, nthr = (size_t)F.G * NWAVES * 64;
    convert_rows(F.in[10], (bf16*)(F.ws + WS_SUBK), (size_t)DEPTH * 8 * 2 * 128 * 128 / 8, gtid, nthr);
    convert_rows(F.in[0], (bf16*)(F.ws + WS_XB), (size_t)T * DM / 8, gtid, nthr);
    float* cosT = (float*)(F.ws + WS_ROPE); float* sinT = cosT + SEQ * 16;
    for (size_t i = gtid; i < (size_t)SEQ * 16; i += nthr) {
        const int pos = (int)(i >> 4), k = (int)(i & 15);
        const float inv = 1.0f / powf(500000.0f, (float)k * (1.0f / 16.0f));
        const float ang = (float)pos * inv;
        cosT[i] = (float)cos((double)ang); sinT[i] = (float)sin((double)ang);
    }
}

__device__ __forceinline__ void kmean_phase(Frame& F) {
    const bf16* KM = (const bf16*)(F.ws + WS_QKV) + (size_t)1 * T * 1024;
    float* KMEAN = (float*)(F.ws + WS_KMEAN);
    LAS float* red = (LAS float*)(F.lds + RING_OFF);
    const int cg = F.tid & 15, rg = F.tid >> 4;
    for (int it = F.vcu; it < 256; it += F.G) {
        const bf16* base = KM + ((size_t)(it >> 4) * SEQ + (size_t)(it & 15) * 256) * 128;
        float s[8] = {0, 0, 0, 0, 0, 0, 0, 0};
#pragma unroll
        for (int i = 0; i < 8; ++i) { const v4u w = *(const GAS v4u*)(base + (size_t)(rg * 8 + i) * 128 + cg * 8);
            s[0] += bflo(w.x); s[1] += bfhi(w.x); s[2] += bflo(w.y); s[3] += bfhi(w.y); s[4] += bflo(w.z); s[5] += bfhi(w.z); s[6] += bflo(w.w); s[7] += bfhi(w.w); }
#pragma unroll
        for (int j = 0; j < 8; ++j) red[rg * 128 + cg * 8 + j] = s[j];
        __syncthreads();
        if (F.tid < 128) { float a = 0.f;
#pragma unroll 8
            for (int g = 0; g < 32; ++g) a += red[g * 128 + F.tid];
            KMEAN[(size_t)it * 128 + F.tid] = a * (1.0f / 256.0f); }
        __syncthreads();
    }
}

__device__ __forceinline__ int att_fetch(Frame& F, gu32* head) {
    if (F.tid == 0) F.MISC[0] = __hip_atomic_fetch_add(head, 1u, __ATOMIC_RELAXED, __HIP_MEMORY_SCOPE_AGENT);
    __syncthreads();
    const int v = (int)F.MISC[0];
    __syncthreads();
    return v;
}
__device__ __forceinline__ att::BlockRef<bf16, bf16> att_ref(unsigned char* ws, int L) {
    att::BlockRef<bf16, bf16> r;
    const int qb = 15 - L / 48, rem = L % 48;
    const bf16* QKV = (const bf16*)(ws + WS_QKV); const size_t REG = (size_t)T * 1024;
    r.P0 = qb * 256;
    if (rem >= 16) {
        const int x = rem - 16, b = x >> 4, h = (x >> 2) & 3, comp = (x >> 1) & 1, half = x & 1;
        const size_t qk = ((size_t)(b * 8 + h * 2 + comp) * SEQ) * 128, vv = ((size_t)(b * 8 + h * 2 + half) * SEQ) * 128;
        r.Q = QKV + 3 * REG + qk + (size_t)qb * 256 * 128; r.K = QKV + 4 * REG + qk; r.V = QKV + 5 * REG + vv;
        r.O = (bf16*)(ws + WS_OD) + ((size_t)(((b * 4 + h) * 2 + comp) * 2 + half) * SEQ + (size_t)qb * 256) * 128;
        r.ostride = 128; r.moba = 0; r.kmean = (const float*)(ws + WS_KMEAN);
    } else {
        const int b = rem >> 3, h = rem & 7;
        const size_t hh = ((size_t)(b * 8 + h) * SEQ) * 128;
        r.Q = QKV + hh + (size_t)qb * 256 * 128; r.K = QKV + 1 * REG + hh; r.V = QKV + 2 * REG + hh;
        r.O = (bf16*)(ws + WS_YMD) + ((size_t)b * SEQ + (size_t)qb * 256) * 2048 + h * 128;
        r.ostride = 2048; r.moba = 1; r.kmean = (const float*)(ws + WS_KMEAN) + (size_t)(b * 8 + h) * 16 * 128;
    }
    return r;
}

__device__ __forceinline__ void diffcomb_phase(Frame& F, int l) {
    const float* lamf = F.in[5] + (size_t)l * 4 * 128; const float* sg = F.in[6] + (size_t)l * 256;
    const float lambda_init = 0.8f - 0.6f * expf(-0.3f * (float)l);
    const float d1 = wave_sum(lamf[F.lane] * lamf[128 + F.lane] + lamf[64 + F.lane] * lamf[128 + 64 + F.lane]);
    const float d2 = wave_sum(lamf[256 + F.lane] * lamf[384 + F.lane] + lamf[256 + 64 + F.lane] * lamf[384 + 64 + F.lane]);
    const float lam = expf(d1) - expf(d2) + lambda_init;
    const bf16* OD = (const bf16*)(F.ws + WS_OD); bf16* YD = (bf16*)(F.ws + WS_YMD) + 1024;
    const int gw = F.vcu * NWAVES + F.wave, NGW = F.G * NWAVES;
    const int half = F.lane >> 5, c4 = (F.lane & 31) * 4;
    const f32x4 g4 = *(const GAS f32x4*)(sg + half * 128 + c4);
    for (int it0 = gw; it0 < T * 4; it0 += 8 * NGW) {
        unsigned long long wa[8], wb[8];
#pragma unroll
        for (int u = 0; u < 8; ++u) { const int it = min(it0 + u * NGW, T * 4 - 1);
            const int t = it >> 2, h = it & 3, b = t >> 12, s = t & 4095;
            const size_t o0 = ((size_t)(((b * 4 + h) * 2 + 0) * 2 + half) * SEQ + s) * 128 + c4;
            const size_t o1 = ((size_t)(((b * 4 + h) * 2 + 1) * 2 + half) * SEQ + s) * 128 + c4;
            wa[u] = *(const GAS unsigned long long*)(OD + o0); wb[u] = *(const GAS unsigned long long*)(OD + o1); }
        asm volatile("" : "+v"(wa[0]), "+v"(wa[1]), "+v"(wa[2]), "+v"(wa[3]), "+v"(wa[4]), "+v"(wa[5]), "+v"(wa[6]), "+v"(wa[7]),
                          "+v"(wb[0]), "+v"(wb[1]), "+v"(wb[2]), "+v"(wb[3]), "+v"(wb[4]), "+v"(wb[5]), "+v"(wb[6]), "+v"(wb[7]));
#pragma unroll
        for (int u = 0; u < 8; ++u) { const int it = it0 + u * NGW; if (it < T * 4) {
            const int t = it >> 2, h = it & 3;
            const f32x4 a = {bflo((unsigned)wa[u]), bfhi((unsigned)wa[u]), bflo((unsigned)(wa[u] >> 32)), bfhi((unsigned)(wa[u] >> 32))}, bb = {bflo((unsigned)wb[u]), bfhi((unsigned)wb[u]), bflo((unsigned)(wb[u] >> 32)), bfhi((unsigned)(wb[u] >> 32))};
            const f32x4 o = a - bb * lam;
            const float ss = wave_sum(o[0] * o[0] + o[1] * o[1] + o[2] * o[2] + o[3] * o[3]);
            const float rs = 1.0f / sqrtf(ss * (1.0f / 256.0f) + RMS_EPS) * (1.0f - lambda_init);
            const f32x4 y = o * rs * g4;
            unsigned long long pk = (unsigned long long)pk2(y[0], y[1]) | ((unsigned long long)pk2(y[2], y[3]) << 32);
            *(GAS unsigned long long*)(YD + (size_t)t * 2048 + h * 256 + half * 128 + c4) = pk; } }
    }
}

__device__ __forceinline__ void ln1_phase(Frame& F, int l) {
    const float* Y = (const float*)(F.ws + WS_MF); bf16* X1B = (bf16*)(F.ws + WS_X1B);
    const float* g = F.in[7] + (size_t)l * DM; const float* bta = F.in[8] + (size_t)l * DM;
    const int gw = F.vcu * NWAVES + F.wave, NGW = F.G * NWAVES;
    for (int m = gw; m < T; m += NGW) {
        const GAS f32x4* xr = (const GAS f32x4*)(Y + (size_t)m * DM) + F.lane;
        f32x4 v[8]; float s = 0.f;
#pragma unroll
        for (int j = 0; j < 8; ++j) { v[j] = xr[64 * j]; s += (v[j].x + v[j].y) + (v[j].z + v[j].w); }
        const float mean = wave_sum(s) * (1.f / DM); float s2 = 0.f;
#pragma unroll
        for (int j = 0; j < 8; ++j) { v[j] = v[j] - mean; s2 += (v[j].x * v[j].x + v[j].y * v[j].y) + (v[j].z * v[j].z + v[j].w * v[j].w); }
        const float rstd = 1.f / sqrtf(wave_sum(s2) * (1.f / DM) + LN_EPS);
        GAS unsigned long long* o8 = (GAS unsigned long long*)(X1B + (size_t)m * DM) + F.lane;
#pragma unroll
        for (int j = 0; j < 8; ++j) { const f32x4 gg = ((const GAS f32x4*)g)[F.lane + 64 * j], bb = ((const GAS f32x4*)bta)[F.lane + 64 * j];
            const f32x4 y = v[j] * rstd * gg + bb;
            o8[64 * j] = (unsigned long long)pk2(y.x, y.y) | ((unsigned long long)pk2(y.z, y.w) << 32); }
    }
}

__device__ __forceinline__ unsigned mkkey(float f, unsigned low, unsigned mask) {
    unsigned u = __float_as_uint(f); u = (u & 0x80000000u) ? ~u : (u | 0x80000000u); return (u & ~mask) | low; }
__device__ __forceinline__ float keyval(unsigned k, unsigned mask) {
    const unsigned u = k & ~mask; return __uint_as_float((u & 0x80000000u) ? (u & 0x7fffffffu) : ~u); }
#define INS16(L, key_) do { unsigned k_ = (key_); _Pragma("unroll") for (int i_ = 0; i_ < 16; ++i_) { const unsigned h_ = max(L[i_], k_); k_ = min(L[i_], k_); L[i_] = h_; } } while (0)
__device__ __forceinline__ void bitonic_desc16(unsigned (&C)[16]) {
#pragma unroll
    for (int d = 8; d >= 1; d >>= 1)
#pragma unroll
        for (int i = 0; i < 16; ++i) if ((i & d) == 0) { const unsigned a = max(C[i], C[i + d]), b = min(C[i], C[i + d]); C[i] = a; C[i + d] = b; }
}
__device__ __forceinline__ void bitonic_sort16_desc(unsigned (&C)[16]) {
#pragma unroll
    for (int k = 2; k <= 16; k <<= 1)
#pragma unroll
        for (int j = k >> 1; j >= 1; j >>= 1)
#pragma unroll
            for (int i = 0; i < 16; ++i) { const int p = i ^ j; if (p > i) { const unsigned hi_ = max(C[i], C[p]), lo_ = min(C[i], C[p]);
                if ((i & k) == 0) { C[i] = hi_; C[p] = lo_; } else { C[i] = lo_; C[p] = hi_; } } }
}
__device__ __forceinline__ void merge_top16(unsigned (&L)[16], const unsigned (&C)[16]) {
#pragma unroll
    for (int i = 0; i < 16; ++i) L[i] = max(L[i], C[15 - i]);
    bitonic_desc16(L);
}
__device__ __forceinline__ void peer_topk_phase(Frame& F, int l) {
    typedef float f32x16 __attribute__((ext_vector_type(16)));
    const bf16* QP = (const bf16*)(F.ws + WS_QP); const bf16* SK = (const bf16*)(F.ws + WS_SUBK) + (size_t)l * 8 * 2 * 128 * 128;
    int* IDX = (int*)(F.ws + WS_IDX); float* GATE = (float*)(F.ws + WS_GATE);
    const int gw = F.vcu * NWAVES + F.wave, NGW = F.G * NWAVES;
    const int r32 = F.lane & 31, hi = F.lane >> 5;
    for (int it = gw; it < 2048; it += NGW) {
        const int h = it >> 8, g = it & 255, t = g * 32 + r32;
        unsigned LA[16], LB[16];
#pragma unroll
        for (int c = 0; c < 2; ++c) {
            bf16x8 qf[8];
#pragma unroll
            for (int d0 = 0; d0 < 8; ++d0) qf[d0] = *(const GAS bf16x8*)(QP + (size_t)t * DM + h * 256 + c * 128 + d0 * 16 + hi * 8);
            unsigned L[16];
#pragma unroll
            for (int i = 0; i < 16; ++i) L[i] = 0u;
#pragma unroll
            for (int nt = 0; nt < 4; ++nt) {
                f32x16 p = {0, 0, 0, 0, 0, 0, 0, 0, 0, 0, 0, 0, 0, 0, 0, 0};
                const bf16* kr = SK + ((size_t)(h * 2 + c) * 128 + nt * 32 + r32) * 128 + hi * 8;
#pragma unroll
                for (int d0 = 0; d0 < 8; ++d0) { const bf16x8 kf = *(const GAS bf16x8*)(kr + d0 * 16);
                    p = __builtin_amdgcn_mfma_f32_32x32x16_bf16(kf, qf[d0], p, 0, 0, 0); }
                unsigned Kx[16];
#pragma unroll
                for (int r = 0; r < 16; ++r) { const int n = nt * 32 + (r & 3) + 8 * (r >> 2) + 4 * hi;
                    Kx[r] = mkkey(p[r], (unsigned)(127 - n), 127u); }
                bitonic_sort16_desc(Kx);
                if (nt == 0) {
#pragma unroll
                    for (int i = 0; i < 16; ++i) L[i] = Kx[i];
                } else merge_top16(L, Kx);
            }
            unsigned C[16];
#pragma unroll
            for (int i = 0; i < 16; ++i) { const unsigned o = (unsigned)__shfl_xor((int)L[15 - i], 32); C[i] = max(L[i], o); }
            bitonic_desc16(C);
#pragma unroll
            for (int i = 0; i < 16; ++i) { if (c == 0) LA[i] = C[i]; else LB[i] = C[i]; }
        }
        float a[16], b[16];
#pragma unroll
        for (int i = 0; i < 16; ++i) { a[i] = keyval(LA[i], 127u); b[i] = keyval(LB[i], 127u); }
#define CK(i, j) mkkey(a[i] + b[j], (unsigned)(255 - ((i) * 16 + (j))), 255u)
        unsigned M[16], G[16];
#pragma unroll
        for (int j = 0; j < 16; ++j) M[j] = CK(0, j);
#pragma unroll
        for (int j = 0; j < 8; ++j) { G[j] = CK(1, j); G[15 - j] = CK(8 + j, 0); }
        bitonic_desc16(G); merge_top16(M, G);
        G[0] = CK(2, 0); G[1] = CK(2, 1); G[2] = CK(2, 2); G[3] = CK(2, 3); G[4] = CK(2, 4); G[5] = CK(3, 0); G[6] = CK(3, 1); G[7] = CK(3, 2); G[8] = CK(3, 3);
        G[9] = CK(4, 0); G[10] = CK(4, 1); G[11] = CK(4, 2); G[12] = CK(5, 0); G[13] = CK(5, 1); G[14] = 0u; G[15] = 0u;
        bitonic_sort16_desc(G); merge_top16(M, G);
        INS16(M, CK(6, 0)); INS16(M, CK(6, 1)); INS16(M, CK(7, 0)); INS16(M, CK(7, 1));
#undef CK
        float e[16]; float se = 0.f; const float m0 = keyval(M[0], 255u);
#pragma unroll
        for (int k = 0; k < 16; ++k) { e[k] = __expf(keyval(M[k], 255u) - m0); se += e[k]; }
        const float inv = 1.0f / se;
        int ex[8]; float gt[8];
#pragma unroll
        for (int kk = 0; kk < 8; ++kk) {
            const unsigned mk = hi ? M[8 + kk] : M[kk]; gt[kk] = (hi ? e[8 + kk] : e[kk]) * inv;
            const int code = 255 - (int)(mk & 255u), ci = code >> 4, cj = code & 15;
            unsigned ka = 0u, kb = 0u;
#pragma unroll
            for (int q = 0; q < 16; ++q) { ka = (ci == q) ? LA[q] : ka; kb = (cj == q) ? LB[q] : kb; }
            ex[kk] = (127 - (int)(ka & 127u)) * 128 + (127 - (int)(kb & 127u));
        }
        int* ip = IDX + (size_t)t * 128 + h * 16 + hi * 8; float* gp = GATE + (size_t)t * 128 + h * 16 + hi * 8;
        *(GAS v4u*)ip = (v4u){(unsigned)ex[0], (unsigned)ex[1], (unsigned)ex[2], (unsigned)ex[3]};
        *(GAS v4u*)(ip + 4) = (v4u){(unsigned)ex[4], (unsigned)ex[5], (unsigned)ex[6], (unsigned)ex[7]};
        *(GAS f32x4*)gp = (f32x4){gt[0], gt[1], gt[2], gt[3]};
        *(GAS f32x4*)(gp + 4) = (f32x4){gt[4], gt[5], gt[6], gt[7]};
    }
}

typedef float f32x2 __attribute__((ext_vector_type(2)));
typedef unsigned u32x8 __attribute__((ext_vector_type(8)));
typedef _Float16 h2 __attribute__((ext_vector_type(2)));
typedef _Float16 h32 __attribute__((ext_vector_type(32)));
typedef __attribute__((__vector_size__(2 * sizeof(__fp16)))) __fp16 fp16x2_t;
__device__ __forceinline__ float gelu_exact(float x) { return 0.5f * x * (1.0f + erff(x * 0.70710678118654752f)); }
__device__ __forceinline__ float dpp_row_shr(float v, int n) {
    const int iv = __builtin_bit_cast(int, v); int r;
    switch (n) { case 1: r = __builtin_amdgcn_update_dpp(0, iv, 0x111, 0xf, 0xf, true); break; case 2: r = __builtin_amdgcn_update_dpp(0, iv, 0x112, 0xf, 0xf, true); break;
                 case 4: r = __builtin_amdgcn_update_dpp(0, iv, 0x114, 0xf, 0xf, true); break; default: r = __builtin_amdgcn_update_dpp(0, iv, 0x118, 0xf, 0xf, true); break; }
    return __builtin_bit_cast(float, r);
}
__device__ __forceinline__ float group_sum16(float v) { v += __shfl_xor(v, 1); v += __shfl_xor(v, 2); v += __shfl_xor(v, 4); v += __shfl_xor(v, 8); return v; }
__device__ __forceinline__ void sort128g(u32x8& K, int j) {
#pragma unroll
    for (int size = 2; size <= 128; size <<= 1)
#pragma unroll
        for (int stride = size >> 1; stride >= 1; stride >>= 1) {
            if (stride >= 16) { const int rs = stride >> 4;
#pragma unroll
                for (int r = 0; r < 8; ++r) if ((r & rs) == 0) { const bool up = (((r * 16) & size) == 0);
                    const unsigned a = K[r], b = K[r | rs], lo = min(a, b), hi = max(a, b); K[r] = up ? lo : hi; K[r | rs] = up ? hi : lo; }
            } else {
#pragma unroll
                for (int r = 0; r < 8; ++r) { const unsigned o = (unsigned)__shfl_xor((int)K[r], stride);
                    const bool up = (((r * 16 + j) & size) == 0), lower = ((j & stride) == 0);
                    K[r] = (up == lower) ? min(K[r], o) : max(K[r], o); }
            }
        }
}
struct RowBuf { v4u d[6]; };
template <int MODE>
__device__ __forceinline__ unsigned row_issue(RowBuf& b, const unsigned char* table, const volatile LAS unsigned* KLq, const volatile LAS _Float16* TCq, int p, int j) {
    const unsigned key = KLq[p < 127 ? p : 127];
    const unsigned char* src = table + (size_t)(((key >> 7) & 16383u) * (unsigned)ROW6 + (unsigned)j * 16u);
#pragma unroll
    for (int n = 0; n < 6; ++n) b.d[n] = *(const GAS v4u*)(src + 256 * n);
    if (MODE == 0) return key & 127u;
    const _Float16 c_ = TCq[key & 127u]; return (unsigned)__builtin_bit_cast(unsigned short, c_);
}
template <int MODE>
__device__ __forceinline__ void row_consume(const RowBuf& b, const unsigned e, volatile LAS _Float16* TCq, int j, h2 (&xa)[64]) {
    if (MODE == 0) {
        float s0 = 0.f, s1 = 0.f;
#pragma unroll
        for (int g = 0; g < 4; ++g) { const u32x6 w = {b.d[(6 * g) >> 2][(6 * g) & 3], b.d[(6 * g + 1) >> 2][(6 * g + 1) & 3], b.d[(6 * g + 2) >> 2][(6 * g + 2) & 3], b.d[(6 * g + 3) >> 2][(6 * g + 3) & 3], b.d[(6 * g + 4) >> 2][(6 * g + 4) & 3], b.d[(6 * g + 5) >> 2][(6 * g + 5) & 3]};
            const h32 r = __builtin_amdgcn_cvt_scalef32_pk32_f16_fp6(w, 1.0f);
#pragma unroll
            for (int m = 0; m < 16; m += 2) {
                s0 = __builtin_amdgcn_fdot2(__builtin_bit_cast(fp16x2_t, (h2){r[2 * m], r[2 * m + 1]}), __builtin_bit_cast(fp16x2_t, xa[16 * g + m]), s0, false);
                s1 = __builtin_amdgcn_fdot2(__builtin_bit_cast(fp16x2_t, (h2){r[2 * m + 2], r[2 * m + 3]}), __builtin_bit_cast(fp16x2_t, xa[16 * g + m + 1]), s1, false); } }
        float s = s0 + s1;
        s += dpp_row_shr(s, 1); s += dpp_row_shr(s, 2); s += dpp_row_shr(s, 4); s += dpp_row_shr(s, 8);
        if (j == 15) TCq[e] = (_Float16)s;
    } else {
        const _Float16 cq = __builtin_bit_cast(_Float16, (unsigned short)e); const h2 c2 = {cq, cq};
#pragma unroll
        for (int g = 0; g < 4; ++g) { const u32x6 w = {b.d[(6 * g) >> 2][(6 * g) & 3], b.d[(6 * g + 1) >> 2][(6 * g + 1) & 3], b.d[(6 * g + 2) >> 2][(6 * g + 2) & 3], b.d[(6 * g + 3) >> 2][(6 * g + 3) & 3], b.d[(6 * g + 4) >> 2][(6 * g + 4) & 3], b.d[(6 * g + 5) >> 2][(6 * g + 5) & 3]};
            const h32 r = __builtin_amdgcn_cvt_scalef32_pk32_f16_fp6(w, 1.0f);
#pragma unroll
            for (int m = 0; m < 16; ++m) xa[16 * g + m] = __builtin_elementwise_fma((h2){r[2 * m], r[2 * m + 1]}, c2, xa[16 * g + m]); }
    }
}
template <int MODE>
__device__ __forceinline__ void sweep4(const unsigned char* table, h2 (&xa)[64], const volatile LAS unsigned* KLq, volatile LAS _Float16* TCq, const int j) {
    RowBuf b0, b1, b2, b3;
    unsigned e0 = row_issue<MODE>(b0, table, KLq, TCq, 0, j), e1 = row_issue<MODE>(b1, table, KLq, TCq, 1, j), e2 = row_issue<MODE>(b2, table, KLq, TCq, 2, j), e3 = row_issue<MODE>(b3, table, KLq, TCq, 3, j);
    for (int p = 0; p < 128; p += 4) {
        row_consume<MODE>(b0, e0, TCq, j, xa); e0 = row_issue<MODE>(b0, table, KLq, TCq, p + 4, j);
        row_consume<MODE>(b1, e1, TCq, j, xa); e1 = row_issue<MODE>(b1, table, KLq, TCq, p + 5, j);
        row_consume<MODE>(b2, e2, TCq, j, xa); e2 = row_issue<MODE>(b2, table, KLq, TCq, p + 6, j);
        row_consume<MODE>(b3, e3, TCq, j, xa); e3 = row_issue<MODE>(b3, table, KLq, TCq, p + 7, j);
    }
    asm volatile("s_waitcnt vmcnt(0)" ::: "memory");
    asm volatile("s_waitcnt lgkmcnt(0)" ::: "memory");
}
__device__ __forceinline__ void peer_expert_phase(Frame& F, int l, const bool last) {
#define PWS ((unsigned char*)ctx_ld(16))
#define PU ((const unsigned char*)(PWS + WS_PU8 + (size_t)l * NEXP * ROW6))
#define PV ((const unsigned char*)(PWS + WS_PV8 + (size_t)l * NEXP * ROW6))
#define SU ((const float*)(PWS + WS_SCL) + (size_t)l * NEXP)
#define SV ((const float*)(PWS + WS_SCL) + (size_t)(2 + l) * NEXP)
#define X1B_ ((const bf16*)(PWS + WS_X1B))
#define RSP_ ((const float*)(PWS + WS_RSP) + (size_t)l * T * 64)
#define IDX ((const int*)(PWS + WS_IDX))
#define GATE ((const float*)(PWS + WS_GATE))
    const int gw = F.vcu * NWAVES + F.wave, NGW = F.G * NWAVES;
    volatile LAS unsigned* KL = (volatile LAS unsigned*)(F.lds + RING_OFF + F.wave * 2048);
    volatile LAS _Float16* TC = (volatile LAS _Float16*)(F.lds + PEER_TC16_OFF + F.wave * 1024);
    for (int tg = gw; tg < T / 4; tg += NGW) {
        const int lane_ = opq_tid(0), q = lane_ >> 4, j = lane_ & 15;
        const int t = tg * 4 + q;
        u32x8 K;
        { const int* idx_ = IDX;
#pragma unroll
          for (int r = 0; r < 8; ++r) { const int e = r * 16 + j; K[r] = (((unsigned)idx_[(size_t)t * 128 + e] & 16383u) << 7) | (unsigned)e; } }
        sort128g(K, j);
#pragma unroll
        for (int r = 0; r < 8; ++r) KL[q * 128 + r * 16 + j] = K[r];
        float mu1, rstd1;
        { const float* rs_ = RSP_ + (size_t)t * 64;
          const float s1_ = group_sum16(rs_[2 * j] + rs_[2 * (j + 16)]), s2_ = group_sum16(rs_[2 * j + 1] + rs_[2 * (j + 16) + 1]);
          mu1 = s1_ * (1.f / DM); rstd1 = 1.f / sqrtf(s2_ * (1.f / DM) - mu1 * mu1 + LN_EPS); }
        {
            h2 xr[64];
            { int jx = j; asm volatile("" : "+v"(jx));
              const bf16* x1_ = X1B_ + (size_t)t * DM; const float* g1_ = (const float*)ctx_ld(7) + (size_t)l * DM; const float* b1_ = (const float*)ctx_ld(8) + (size_t)l * DM;
#pragma unroll
              for (int i0 = 0; i0 < 32; i0 += 8) {
                  unsigned long long w[8]; f32x4 gg[8], bb[8];
#pragma unroll
                  for (int u = 0; u < 8; ++u) { const int col = (jx + 16 * (i0 + u)) * 4; w[u] = *(const GAS unsigned long long*)(x1_ + col); gg[u] = *(const GAS f32x4*)(g1_ + col); bb[u] = *(const GAS f32x4*)(b1_ + col); }
                  asm volatile("" : "+v"(w[0]), "+v"(w[1]), "+v"(w[2]), "+v"(w[3]), "+v"(w[4]), "+v"(w[5]), "+v"(w[6]), "+v"(w[7]),
                                    "+v"(gg[0]), "+v"(gg[1]), "+v"(gg[2]), "+v"(gg[3]), "+v"(gg[4]), "+v"(gg[5]), "+v"(gg[6]), "+v"(gg[7]),
                                    "+v"(bb[0]), "+v"(bb[1]), "+v"(bb[2]), "+v"(bb[3]), "+v"(bb[4]), "+v"(bb[5]), "+v"(bb[6]), "+v"(bb[7]));
#pragma unroll
                  for (int u = 0; u < 8; ++u) { const int i = i0 + u; const unsigned lo = (unsigned)w[u], hi = (unsigned)(w[u] >> 32);
                      const f32x4 y = {bflo(lo), bfhi(lo), bflo(hi), bfhi(hi)}; const f32x4 x = (y - mu1) * rstd1 * gg[u] + bb[u];
                      xr[2 * i] = (h2){(_Float16)x[0], (_Float16)x[1]}; xr[2 * i + 1] = (h2){(_Float16)x[2], (_Float16)x[3]}; } } }
            { LAS unsigned char* xs_ = F.lds + RING_OFF + 16384 + F.wave * 16384 + lane_ * 16;
#pragma unroll
              for (int i = 0; i < 16; ++i) { v4u w_; w_[0] = __builtin_bit_cast(unsigned, xr[4 * i]); w_[1] = __builtin_bit_cast(unsigned, xr[4 * i + 1]); w_[2] = __builtin_bit_cast(unsigned, xr[4 * i + 2]); w_[3] = __builtin_bit_cast(unsigned, xr[4 * i + 3]);
                  *(LAS v4u*)(xs_ + i * 1024) = w_; } }
            VM_WAIT(); LDS_WAIT();
            const unsigned char* pu_ = PU;
            sweep4<0>(pu_, xr, KL + q * 128, TC + q * 128, j);
        }
        { int tc = t, jc = j; asm volatile("" : "+v"(tc), "+v"(jc));
          const int* idx_ = IDX; const float* gate_ = GATE; const float* su_ = SU; const float* sv_ = SV;
          int id[8]; float gt[8], suv[8], svv[8];
#pragma unroll
          for (int r = 0; r < 8; ++r) { const int e = r * 16 + jc; id[r] = idx_[(size_t)tc * 128 + e]; gt[r] = gate_[(size_t)tc * 128 + e]; }
          asm volatile("" : "+v"(id[0]), "+v"(id[1]), "+v"(id[2]), "+v"(id[3]), "+v"(id[4]), "+v"(id[5]), "+v"(id[6]), "+v"(id[7]),
                            "+v"(gt[0]), "+v"(gt[1]), "+v"(gt[2]), "+v"(gt[3]), "+v"(gt[4]), "+v"(gt[5]), "+v"(gt[6]), "+v"(gt[7]));
#pragma unroll
          for (int r = 0; r < 8; ++r) { id[r] &= 16383; suv[r] = su_[id[r]]; svv[r] = sv_[id[r]]; }
          asm volatile("" : "+v"(suv[0]), "+v"(suv[1]), "+v"(suv[2]), "+v"(suv[3]), "+v"(suv[4]), "+v"(suv[5]), "+v"(suv[6]), "+v"(suv[7]),
                            "+v"(svv[0]), "+v"(svv[1]), "+v"(svv[2]), "+v"(svv[3]), "+v"(svv[4]), "+v"(svv[5]), "+v"(svv[6]), "+v"(svv[7]));
#pragma unroll
          for (int r = 0; r < 8; ++r) { const int e = r * 16 + jc;
              const float c = gt[r] * svv[r] * gelu_exact((float)TC[q * 128 + e] * suv[r]); TC[q * 128 + e] = (_Float16)c; } }
        LDS_WAIT();
        h2 acch[64];
#pragma unroll
        for (int i = 0; i < 64; ++i) acch[i] = (h2){(_Float16)0.f, (_Float16)0.f};
        { const unsigned char* pv_ = PV; sweep4<1>(pv_, acch, KL + q * 128, TC + q * 128, j); }
        {
            int tl = t, jl = j; asm volatile("" : "+v"(tl), "+v"(jl));
            const float* g = (const float*)ctx_ld(13) + (size_t)l * DM; const float* bta = (const float*)ctx_ld(14) + (size_t)l * DM;
            float* xout = last ? (float*)ctx_ld(15) : (float*)nullptr; bf16* xoutb = last ? (bf16*)nullptr : (bf16*)(PWS + WS_XB);
            f32x4 y[32]; float s = 0.f;
            { const LAS unsigned char* xs_ = F.lds + RING_OFF + 16384 + F.wave * 16384 + lane_ * 16;
#pragma unroll
              for (int i2 = 0; i2 < 16; ++i2) { const v4u w_ = *(const LAS v4u*)(xs_ + i2 * 1024);
#pragma unroll
                  for (int cc = 0; cc < 2; ++cc) { const int i = 2 * i2 + cc; const unsigned ua_ = w_[2 * cc], ub_ = w_[2 * cc + 1]; const h2 xa_ = __builtin_bit_cast(h2, ua_), xb_ = __builtin_bit_cast(h2, ub_);
                      y[i][0] = fmaf(DN_ALPHA, (float)xa_.x, (float)acch[2 * i].x); y[i][1] = fmaf(DN_ALPHA, (float)xa_.y, (float)acch[2 * i].y);
                      y[i][2] = fmaf(DN_ALPHA, (float)xb_.x, (float)acch[2 * i + 1].x); y[i][3] = fmaf(DN_ALPHA, (float)xb_.y, (float)acch[2 * i + 1].y);
                      s += (y[i][0] + y[i][1]) + (y[i][2] + y[i][3]); } } }
            const float mean = group_sum16(s) * (1.f / DM); float s2 = 0.f;
#pragma unroll
            for (int i = 0; i < 32; ++i) { y[i] = y[i] - mean; s2 += (y[i][0] * y[i][0] + y[i][1] * y[i][1]) + (y[i][2] * y[i][2] + y[i][3] * y[i][3]); }
            const float rstd = 1.f / sqrtf(group_sum16(s2) * (1.f / DM) + LN_EPS);
#pragma unroll
            for (int i0 = 0; i0 < 32; i0 += 8) {
                f32x4 gg[8], bb[8];
#pragma unroll
                for (int u = 0; u < 8; ++u) { const int col = (jl + 16 * (i0 + u)) * 4; gg[u] = *(const GAS f32x4*)(g + col); bb[u] = *(const GAS f32x4*)(bta + col); }
                asm volatile("" : "+v"(gg[0]), "+v"(gg[1]), "+v"(gg[2]), "+v"(gg[3]), "+v"(gg[4]), "+v"(gg[5]), "+v"(gg[6]), "+v"(gg[7]),
                                  "+v"(bb[0]), "+v"(bb[1]), "+v"(bb[2]), "+v"(bb[3]), "+v"(bb[4]), "+v"(bb[5]), "+v"(bb[6]), "+v"(bb[7]));
#pragma unroll
                for (int u = 0; u < 8; ++u) { const int col = (jl + 16 * (i0 + u)) * 4;
                    const f32x4 o = y[i0 + u] * rstd * gg[u] + bb[u];
                    if (xout) __builtin_nontemporal_store(o, (GAS f32x4*)(xout + (size_t)tl * DM + col));
                    if (xoutb) *(GAS unsigned long long*)(xoutb + (size_t)tl * DM + col) = (unsigned long long)pk2(o[0], o[1]) | ((unsigned long long)pk2(o[2], o[3]) << 32); } }
        }
    }
}
#undef PWS
#undef PU
#undef PV
#undef SU
#undef SV
#undef X1B_
#undef RSP_
#undef IDX
#undef GATE

constexpr int N_PHASES = 1 + 10 * DEPTH;
#ifndef MK_ONE_LAUNCH
#define MK_ONE_LAUNCH 0
#endif
struct Args { const float* in[15]; float* out; unsigned char* ws; int ph_lo, ph_hi; };
__global__ void __launch_bounds__(NWAVES * 64, 2) mk_fwd(Args args) {
    {
        LAS unsigned char* L = (LAS unsigned char*)lds_all; const int tid = threadIdx.x;
        for (int u = tid; u < (LDS_BYTES - LDSCTL_OFF) / 4; u += NWAVES * 64) ((LAS unsigned*)(L + LDSCTL_OFF))[u] = 0u;
        __syncthreads();
        if (tid < 17) { const unsigned long long v = tid < 15 ? (unsigned long long)args.in[tid] : (tid == 15 ? (unsigned long long)args.out : (unsigned long long)args.ws);
            ((LAS unsigned long long*)(L + CTX_OFF))[tid] = v; }
        __syncthreads();
        if (MK_ONE_LAUNCH) (void)xcd_barrier_post((unsigned*)((gu32*)(args.ws + WS_CTL) + CW_BAR), (volatile LAS unsigned*)(L + MISC_OFF) + 8);
    }
    const int wave_s__ = __builtin_amdgcn_readfirstlane((int)threadIdx.x >> 6);
    const int lo = args.ph_lo, hi = args.ph_hi;
#define IN(k) (lo <= (k) && (k) < hi)
#ifndef PHM
#define PHM 0xFFFF
#endif
#define PHM_ON(k) (((PHM) >> (k)) & 1)
#ifndef REPM
#define REPM 0
#endif
#define REPN(k) (1 + (((REPM) >> (k)) & 1))
#define SEAM(k) do { if (IN(k) && IN((k) + 1)) { XcdBarrier bar_; bar_.bar = (unsigned*)((gu32*)((unsigned char*)ctx_ld(16) + WS_CTL) + CW_BAR); bar_.x = xb_xcc_id(); bar_.lead = (opq_tid(wave_s__) == 0); \
        bar_.st = (volatile LAS unsigned*)((LAS unsigned char*)lds_all + MISC_OFF) + 8; xcd_barrier(bar_); } } while (0)

    if (PHM_ON(0) && IN(0)) { for (int rep_ = 0; rep_ < REPN(0); ++rep_) { Frame F; mk_frame(F, wave_s__); p0_prologue(F); } }
    SEAM(0);

    for (int l = 0; l < DEPTH; ++l) {
        const int pb = 1 + 10 * l;
        if (PHM_ON(1) && IN(pb + 0)) { for (int rep_ = 0; rep_ < REPN(1); ++rep_) { Frame F; mk_frame(F, wave_s__);
            pg8::Gemm g{(const bf16*)(F.ws + WS_XB), (const bf16*)(F.ws + WS_WIN) + (size_t)l * IN_COLS * DM, T, IN_COLS, DM, DM};
            pg8::StaticOrder S; S.init(T, IN_COLS, F.G, (int)blockIdx.x);
            pg8::EpiIn E{(bf16*)(F.ws + WS_QKV), (bf16*)(F.ws + WS_GATES), (const float*)(F.ws + WS_ROPE), (const float*)(F.ws + WS_ROPE) + SEQ * 16};
            pg8::gemm_phase<pg8::EpiIn, pg8::StaticOrder, true, true>(F.lds + RING_OFF, g, S, E, wave_s__);
        } }
        SEAM(pb + 0);
        if (PHM_ON(2) && IN(pb + 1)) { for (int rep_ = 0; rep_ < REPN(2); ++rep_) { Frame F; mk_frame(F, wave_s__); kmean_phase(F); } }
        SEAM(pb + 1);
        if (PHM_ON(3) && IN(pb + 2)) { for (int rep_ = 0; rep_ < REPN(3); ++rep_) { Frame F; mk_frame(F, wave_s__);
            gu32* head = F.ctl + CW_ATTQ + 64 * l + 32 * rep_;
            { const int ncu = F.G >= 4 * FP6_CUS ? FP6_CUS : (F.G + 3) / 4; if (F.vcu < ncu) convert_fp6_layer(F, l, F.vcu * NWAVES + F.wave, ncu * NWAVES); }
            int L = att_fetch(F, head);
            if (L < 768) {
                att::Seam<bf16> Sm;
                att::BlockRef<bf16, bf16> cur = att_ref(F.ws, L);
                att::causal_swa_prime<bf16, bf16>(cur, SEQ, (char*)lds_all + RING_OFF, Sm, wave_s__);
                for (;;) {
                    const int Ln = att_fetch(F, head); const bool more = Ln < 768;
                    const att::BlockRef<bf16, bf16> nxt = more ? att_ref((unsigned char*)ctx_ld(16), Ln) : cur;
                    att::causal_swa_block<bf16, bf16>(cur, nxt, SEQ, SEQ, (char*)lds_all + RING_OFF, Sm, wave_s__);
                    if (!more) break;
                    cur = nxt;
                }
            }
        } }
        SEAM(pb + 2);
        if (PHM_ON(4) && IN(pb + 3)) { for (int rep_ = 0; rep_ < REPN(4); ++rep_) { Frame F; mk_frame(F, wave_s__); diffcomb_phase(F, l); } }
        SEAM(pb + 3);
        if (PHM_ON(5) && IN(pb + 4)) { for (int rep_ = 0; rep_ < REPN(5); ++rep_) { Frame F; mk_frame(F, wave_s__);
            pg8::PairOrder S; S.init(T, DM, F.G, (int)blockIdx.x, 1024 * 2);
            pg8::Gemm g{(const bf16*)(F.ws + WS_YMD), (const bf16*)(F.ws + WS_WBR) + (size_t)l * DM * DM, T, DM, 1024, DM};
            pg8::EpiBr E{(bf16*)(F.ws + WS_MB), (const bf16*)(F.ws + WS_GATES), (const bf16*)(F.ws + WS_GATES) + (size_t)T * DM};
            pg8::gemm_phase<pg8::EpiBr, pg8::PairOrder, true, true>(F.lds + RING_OFF, g, S, E, wave_s__);
        } }
        SEAM(pb + 4);
        if (PHM_ON(6) && IN(pb + 5)) { for (int rep_ = 0; rep_ < REPN(6); ++rep_) { Frame F; mk_frame(F, wave_s__);
            pg8::Gemm g{(const bf16*)(F.ws + WS_MB), (const bf16*)(F.ws + WS_WOUT) + (size_t)l * DM * DM, T, DM, DM, DM};
            pg8::StaticOrder S; S.init(T, DM, F.G, (int)blockIdx.x);
            pg8::EpiOut E{(l == 0) ? F.in[0] : (const float*)nullptr, (const bf16*)(F.ws + WS_XB), (bf16*)(F.ws + WS_X1B), (float*)(F.ws + WS_RSP) + (size_t)l * T * 64};
            pg8::gemm_phase<pg8::EpiOut, pg8::StaticOrder, true, true>(F.lds + RING_OFF, g, S, E, wave_s__);
        } }
        SEAM(pb + 5);
        if (PHM_ON(8) && IN(pb + 7)) { for (int rep_ = 0; rep_ < REPN(8); ++rep_) { Frame F; mk_frame(F, wave_s__);
            pg8::Gemm g{(const bf16*)(F.ws + WS_X1B), (const bf16*)(F.ws + WS_WQ) + (size_t)l * DM * DM, T, DM, DM, DM};
            pg8::StaticOrder S; S.init(T, DM, F.G, (int)blockIdx.x);
            LAS float* tab = (LAS float*)(F.lds + PEER_TC_OFF);
            { pg8::Unit u0; const bool has = S.next(0, u0);
              if (has) { const int i = F.tid & 255;
                if (F.tid < 256) { const float* rp = (const float*)(F.ws + WS_RSP) + ((size_t)l * T + (size_t)u0.pm * 256 + i) * 64; float s1 = 0.f, s2 = 0.f;
#pragma unroll 8
                    for (int q = 0; q < 32; ++q) { s1 += rp[2 * q]; s2 += rp[2 * q + 1]; }
                    const float mu = s1 * (1.f / DM); tab[i] = mu; tab[256 + i] = 1.f / sqrtf(s2 * (1.f / DM) - mu * mu + LN_EPS); }
                else { const float* p1 = (const float*)(F.ws + WS_C1P) + (size_t)l * 32 * DM + u0.pn * 256 + i; const float* p2 = (const float*)(F.ws + WS_C2P) + (size_t)l * 32 * DM + u0.pn * 256 + i; float a1 = 0.f, a2 = 0.f;
#pragma unroll 8
                    for (int q = 0; q < 32; ++q) { a1 += p1[(size_t)q * DM]; a2 += p2[(size_t)q * DM]; }
                    tab[512 + i] = a1; tab[768 + i] = a2; } }
              __syncthreads(); }
            pg8::EpiQ E{(bf16*)(F.ws + WS_QP), tab};
            pg8::gemm_phase<pg8::EpiQ, pg8::StaticOrder, true, true>(F.lds + RING_OFF, g, S, E, wave_s__);
        } }
        SEAM(pb + 7);
        if (PHM_ON(9) && IN(pb + 8)) { for (int rep_ = 0; rep_ < REPN(9); ++rep_) { Frame F; mk_frame(F, wave_s__); peer_topk_phase(F, l); } }
        SEAM(pb + 8);
        if (PHM_ON(10) && IN(pb + 9)) { for (int rep_ = 0; rep_ < REPN(10); ++rep_) { Frame F; mk_frame(F, wave_s__);
            peer_expert_phase(F, l, l == DEPTH - 1); } }
        SEAM(pb + 9);
    }
#undef IN
#undef SEAM
}

extern "C" void kernel_launch(void* const* d_in, const int* in_sizes, int n_in, void* d_out, int out_size, void* d_ws, size_t ws_size, hipStream_t stream) {
    static int grid = 0;
    if (grid == 0) {
        if (n_in != 15 || in_sizes[0] != T * DM || out_size != T * DM || ws_size < WS_END) {
            fprintf(stderr, "kernel_launch: expected 15 inputs, x/out of %d floats, >= %zu bytes of workspace; got n_in %d in0 %d out %d ws %zu\n", T * DM, (size_t)WS_END, n_in, n_in > 0 ? in_sizes[0] : -1, out_size, ws_size);
            grid = -1; return; }
        int dev = 0, cus = 0, per_cu = 0;
        if (hipGetDevice(&dev) != hipSuccess || hipDeviceGetAttribute(&cus, hipDeviceAttributeMultiprocessorCount, dev) != hipSuccess) { grid = -1; return; }
        if (hipFuncSetAttribute((const void*)mk_fwd, hipFuncAttributeMaxDynamicSharedMemorySize, LDS_BYTES) != hipSuccess) { fprintf(stderr, "kernel_launch: hipFuncSetAttribute failed\n"); grid = -1; return; }
        if (hipOccupancyMaxActiveBlocksPerMultiprocessor(&per_cu, (const void*)mk_fwd, NWAVES * 64, LDS_BYTES) != hipSuccess || per_cu < 1)
            fprintf(stderr, "kernel_launch: occupancy query reports %d workgroups per CU\n", per_cu);
        (void)hipGetLastError();
        grid = cus;
    }
    if (grid < 0) return;
    if (hipMemsetAsync((char*)d_ws + WS_CTL, 0, CTL_ZERO_BYTES, stream) != hipSuccess) { fprintf(stderr, "kernel_launch: memset failed\n"); return; }
    Args a{};
    for (int i = 0; i < 15; ++i) a.in[i] = (const float*)d_in[i];
    a.out = (float*)d_out; a.ws = (unsigned char*)d_ws;
    if (MK_ONE_LAUNCH) {
        a.ph_lo = 0; a.ph_hi = N_PHASES;
        hipLaunchKernelGGL(mk_fwd, dim3(grid), dim3(NWAVES * 64), LDS_BYTES, stream, a);
    } else {
        for (int p = 0; p < N_PHASES; ++p) { a.ph_lo = p; a.ph_hi = p + 1; hipLaunchKernelGGL(mk_fwd, dim3(grid), dim3(NWAVES * 64), LDS_BYTES, stream, a); }
    }
    const hipError_t le = hipPeekAtLastError();
    if (le != hipSuccess) fprintf(stderr, "kernel_launch: launch failed: %s\n", hipGetErrorName(le));
}
```

```cpp
#include <hip/hip_runtime.h>
#include <cstdio>
#include <cstdint>
#define MK_ONE_LAUNCH 1
#define REPM 0
#define PEER_PROBE 0
#define BAR_PROBE 0
#define FP8_EMU 0
#define SP2_SMALL true
#define SP2_IN true
#define FP4_EMU 0
#define CODE_PAD 0
__device__ __forceinline__ int opq_tid(int wave_s) { int l; asm volatile("v_mbcnt_lo_u32_b32 %0, -1, 0\n\tv_mbcnt_hi_u32_b32 %0, -1, %0" : "=v"(l)); return (wave_s << 6) | l; }
namespace pg8 {
#define PG8_LAS __attribute__((address_space(3)))
typedef unsigned short bf16_t;
typedef short bf16x8 __attribute__((ext_vector_type(8)));
typedef float f32x4 __attribute__((ext_vector_type(4)));
typedef unsigned u32x4 __attribute__((ext_vector_type(4)));
constexpr int BM = 256, BK = 64, HALF = 128, HTB = HALF * BK * 2  , STAGE_BYTES = 8 * HTB, NXCD = 8, WGM = 8;

__host__ __device__ __forceinline__ int lds_byte(int r, int c) { const int st = (r >> 4) * 2 + (c >> 5), rr = r & 15, cc = c & 31, ob = rr * 64 + cc * 2; return st * 1024 + (ob ^ (((ob >> 9) & 1) << 5)); }
__host__ __device__ __forceinline__ void stage_rc(int b, int& R, int& C) { const int st = b / 1024, sb = b % 1024, swz = sb ^ (((sb >> 9) & 1) << 5); R = (st >> 1) * 16 + swz / 64; C = (st & 1) * 32 + (swz % 64) / 2; }
__host__ __device__ __forceinline__ int perm32(int rho) { const int n = rho >> 4, i = rho & 15; return 8 * (i >> 2) + 4 * n + (i & 3); }

struct Unit { int pm, pn, kb; };
struct Gemm { const bf16_t* A; const bf16_t* Bt; int M, N, K, ld; };

struct StaticOrder {
    int nM, nN, nwg, G, c;
    __host__ __device__ __forceinline__ void init(int M, int N, int G_, int c_) { nM = M / BM; nN = N / BM; nwg = nM * nN; G = G_; c = c_; }
    __host__ __device__ __forceinline__ bool next(int i, Unit& u) const {
        const long L = (long)i * G + c; if (L >= nwg) return false;
        int wgid = (int)L; { const int q = nwg / NXCD, r = nwg % NXCD, xcd = wgid % NXCD, off = wgid / NXCD; wgid = (xcd < r ? xcd * (q + 1) : r * (q + 1) + (xcd - r) * q) + off; }
        const int nig = WGM * nN, gid = wgid / nig, fm = gid * WGM, gsz = (nM - fm) < WGM ? (nM - fm) : WGM;
        u.pm = fm + ((wgid % nig) % gsz); u.pn = (wgid % nig) / gsz; u.kb = 0; return true;
    }
    __device__ __forceinline__ void a_ready(const Unit&) const {}
    __device__ __forceinline__ void done(const Unit&) const {}
};
__device__ __forceinline__ unsigned cvt_pk_bf16(float lo, float hi) { unsigned r; asm volatile("v_cvt_pk_bf16_f32 %0, %1, %2" : "=v"(r) : "v"(lo), "v"(hi)); return r; }
__device__ __forceinline__ void st_bf16x4(bf16_t* p, f32x4 v) {
    const unsigned long long w = (unsigned long long)cvt_pk_bf16(v[0], v[1]) | ((unsigned long long)cvt_pk_bf16(v[2], v[3]) << 32);
    *(unsigned long long*)p = w;
}
__device__ __forceinline__ f32x4 cvt_bf16x4(unsigned long long w) {
    const unsigned lo = (unsigned)w, hi = (unsigned)(w >> 32);
    return (f32x4){__uint_as_float(lo << 16), __uint_as_float(lo & 0xffff0000u), __uint_as_float(hi << 16), __uint_as_float(hi & 0xffff0000u)};
}
__device__ __forceinline__ f32x4 ld_bf16x4(const bf16_t* p) {
    const unsigned long long w = *(const unsigned long long*)p; const unsigned lo = (unsigned)w, hi = (unsigned)(w >> 32);
    return (f32x4){__uint_as_float(lo << 16), __uint_as_float(lo & 0xffff0000u), __uint_as_float(hi << 16), __uint_as_float(hi & 0xffff0000u)};
}
struct EpiIn {
    static constexpr bool PERM = false, AFTER_DRAIN = false, MIDK = false;
    bf16_t* qkv; bf16_t* gates; const float* cosT; const float* sinT;
    __device__ __forceinline__ void operator()(const f32x4 (&acc)[2][2][4][2], const Unit& u, int wr, int wc, int fr, int fq) const {
        const int pn = u.pn;
        if (pn < 24) {
            const int reg = pn >> 2;
            const bool rope = (reg == 0 || reg == 1 || reg == 3 || reg == 4) && (wc == 0);
            f32x4 csv[8], snv[8];
#pragma unroll
            for (int q = 0; q < 8; ++q) { csv[q] = (f32x4){1.f, 1.f, 1.f, 1.f}; snv[q] = (f32x4){0.f, 0.f, 0.f, 0.f}; }
            if (rope) {
#pragma unroll
                for (int q = 0; q < 8; ++q) { const int s = (u.pm * BM + (q >> 2) * HALF + wr * 64 + (q & 3) * 16 + fr) & 4095;
                    csv[q] = *(const f32x4*)(cosT + s * 16 + 4 * fq); snv[q] = *(const f32x4*)(sinT + s * 16 + 4 * fq); }
                asm volatile("" : "+v"(csv[0]), "+v"(csv[1]), "+v"(csv[2]), "+v"(csv[3]), "+v"(csv[4]), "+v"(csv[5]), "+v"(csv[6]), "+v"(csv[7]),
                                  "+v"(snv[0]), "+v"(snv[1]), "+v"(snv[2]), "+v"(snv[3]), "+v"(snv[4]), "+v"(snv[5]), "+v"(snv[6]), "+v"(snv[7]));
            }
#pragma unroll
            for (int ai = 0; ai < 2; ++ai)
#pragma unroll
                for (int m = 0; m < 4; ++m) {
                    const int row = u.pm * BM + ai * HALF + wr * 64 + m * 16 + fr, b = row >> 12, s = row & 4095;
                    const f32x4 cs = csv[ai * 4 + m], sn = snv[ai * 4 + m];
#pragma unroll
                    for (int bj = 0; bj < 2; ++bj) {
                        const int chunk = (pn & 3) * 2 + bj;
                        bf16_t* dst = qkv + (size_t)reg * (8192u * 1024u) + ((size_t)(b * 8 + chunk) * 4096 + s) * 128 + wc * 32 + 4 * fq;
                        f32x4 v0 = acc[ai][bj][m][0], v1 = acc[ai][bj][m][1];
                        if (rope) { const f32x4 a = v0 * cs - v1 * sn, bb = v0 * sn + v1 * cs; v0 = a; v1 = bb; }
                        st_bf16x4(dst, v0); st_bf16x4(dst + 16, v1);
                    }
                }
        } else {
            const int gi = (pn - 24) >> 3, colt = ((pn - 24) & 7) * BM;
#pragma unroll
            for (int ai = 0; ai < 2; ++ai)
#pragma unroll
                for (int m = 0; m < 4; ++m) {
                    const int row = u.pm * BM + ai * HALF + wr * 64 + m * 16 + fr;
                    bf16_t* rowp = gates + (size_t)gi * (8192u * 2048u) + (size_t)row * 2048 + colt + wc * 32 + 4 * fq;
#pragma unroll
                    for (int bj = 0; bj < 2; ++bj)
#pragma unroll
                        for (int n = 0; n < 2; ++n) { const f32x4 x = acc[ai][bj][m][n]; f32x4 y;
#pragma unroll
                            for (int j = 0; j < 4; ++j) y[j] = 1.0f / (1.0f + __expf(-x[j]));
                            st_bf16x4(rowp + bj * HALF + n * 16, y); }
                }
        }
    }
};
struct EpiBr {
    static constexpr bool PERM = false, AFTER_DRAIN = false, MIDK = true;
    bf16_t* MB; const bf16_t* GM; const bf16_t* GD;
    __device__ __forceinline__ void mid(f32x4 (&acc)[2][2][4][2], const Unit& u, int wr, int wc, int fr, int fq) const {
#pragma unroll
        for (int ai = 0; ai < 2; ++ai)
#pragma unroll
            for (int m = 0; m < 4; ++m) { const size_t off = (size_t)(u.pm * BM + ai * HALF + wr * 64 + m * 16 + fr) * 2048 + u.pn * BM + wc * 32 + 4 * fq;
                unsigned long long gmw[4], gdw[4];
#pragma unroll
                for (int q = 0; q < 4; ++q) { const size_t o = off + (q >> 1) * HALF + (q & 1) * 16; gmw[q] = *(const unsigned long long*)(GM + o); gdw[q] = *(const unsigned long long*)(GD + o); }
                asm volatile("" : "+v"(gmw[0]), "+v"(gmw[1]), "+v"(gmw[2]), "+v"(gmw[3]), "+v"(gdw[0]), "+v"(gdw[1]), "+v"(gdw[2]), "+v"(gdw[3]));
#pragma unroll
                for (int q = 0; q < 4; ++q) { const f32x4 gm = cvt_bf16x4(gmw[q]), gd = cvt_bf16x4(gdw[q]); f32x4 r;
#pragma unroll
                    for (int j = 0; j < 4; ++j) r[j] = gm[j] * __builtin_amdgcn_rcpf(gd[j]);
                    acc[ai][q >> 1][m][q & 1] = acc[ai][q >> 1][m][q & 1] * r; }
                asm volatile("" ::: "memory"); }
    }
    __device__ __forceinline__ void operator()(const f32x4 (&acc)[2][2][4][2], const Unit& u, int wr, int wc, int fr, int fq) const {
#pragma unroll
        for (int a2 = 0; a2 < 4; ++a2) {
            unsigned long long gdw[8];
#pragma unroll
            for (int q = 0; q < 8; ++q) { const int g = 2 * a2 + (q >> 2), ai = g >> 2, m = g & 3;
                const size_t o = (size_t)(u.pm * BM + ai * HALF + wr * 64 + m * 16 + fr) * 2048 + u.pn * BM + wc * 32 + 4 * fq + ((q >> 1) & 1) * HALF + (q & 1) * 16;
                gdw[q] = *(const unsigned long long*)(GD + o); }
            asm volatile("" : "+v"(gdw[0]), "+v"(gdw[1]), "+v"(gdw[2]), "+v"(gdw[3]), "+v"(gdw[4]), "+v"(gdw[5]), "+v"(gdw[6]), "+v"(gdw[7]));
#pragma unroll
            for (int q = 0; q < 8; ++q) { const int g = 2 * a2 + (q >> 2), ai = g >> 2, m = g & 3;
                const size_t o = (size_t)(u.pm * BM + ai * HALF + wr * 64 + m * 16 + fr) * 2048 + u.pn * BM + wc * 32 + 4 * fq + ((q >> 1) & 1) * HALF + (q & 1) * 16;
                st_bf16x4(MB + o, acc[ai][(q >> 1) & 1][m][q & 1] * cvt_bf16x4(gdw[q])); }
        }
    }
};
struct EpiOut {
    static constexpr bool PERM = false, AFTER_DRAIN = false, MIDK = false;
    const float* X; const bf16_t* XB; bf16_t* YB; float* RS;
    __device__ __forceinline__ void operator()(const f32x4 (&acc)[2][2][4][2], const Unit& u, int wr, int wc, int fr, int fq) const {
#pragma unroll
        for (int a2 = 0; a2 < 4; ++a2) {
            f32x4 xr[8];
            if (X) {
#pragma unroll
                for (int q = 0; q < 8; ++q) { const int g = 2 * a2 + (q >> 2), ai = g >> 2, m = g & 3;
                    const size_t o = (size_t)(u.pm * BM + ai * HALF + wr * 64 + m * 16 + fr) * 2048 + u.pn * BM + wc * 32 + 4 * fq + ((q >> 1) & 1) * HALF + (q & 1) * 16;
                    xr[q] = *(const f32x4*)(X + o); }
                asm volatile("" : "+v"(xr[0]), "+v"(xr[1]), "+v"(xr[2]), "+v"(xr[3]), "+v"(xr[4]), "+v"(xr[5]), "+v"(xr[6]), "+v"(xr[7]));
            } else {
                unsigned long long xw[8];
#pragma unroll
                for (int q = 0; q < 8; ++q) { const int g = 2 * a2 + (q >> 2), ai = g >> 2, m = g & 3;
                    const size_t o = (size_t)(u.pm * BM + ai * HALF + wr * 64 + m * 16 + fr) * 2048 + u.pn * BM + wc * 32 + 4 * fq + ((q >> 1) & 1) * HALF + (q & 1) * 16;
                    xw[q] = *(const unsigned long long*)(XB + o); }
                asm volatile("" : "+v"(xw[0]), "+v"(xw[1]), "+v"(xw[2]), "+v"(xw[3]), "+v"(xw[4]), "+v"(xw[5]), "+v"(xw[6]), "+v"(xw[7]));
#pragma unroll
                for (int q = 0; q < 8; ++q) xr[q] = cvt_bf16x4(xw[q]);
            }
#pragma unroll
            for (int gg = 0; gg < 2; ++gg) { const int g = 2 * a2 + gg, ai = g >> 2, m = g & 3; const int row = u.pm * BM + ai * HALF + wr * 64 + m * 16 + fr;
                const size_t off = (size_t)row * 2048 + u.pn * BM + wc * 32 + 4 * fq;
                float s1 = 0.f, s2 = 0.f;
#pragma unroll
                for (int bj = 0; bj < 2; ++bj)
#pragma unroll
                    for (int n = 0; n < 2; ++n) { const size_t o = off + bj * HALF + n * 16;
                        const f32x4 y = xr[gg * 4 + bj * 2 + n] * 1.4142135623730951f + acc[ai][bj][m][n]; st_bf16x4(YB + o, y);
                        s1 += (y[0] + y[1]) + (y[2] + y[3]); s2 += (y[0] * y[0] + y[1] * y[1]) + (y[2] * y[2] + y[3] * y[3]); }
                s1 += __shfl_xor(s1, 16); s1 += __shfl_xor(s1, 32); s2 += __shfl_xor(s2, 16); s2 += __shfl_xor(s2, 32);
                if (fq == 0) { float* p = RS + (size_t)row * 64 + (u.pn * 4 + wc) * 2; p[0] = s1; p[1] = s2; } }
        }
    }
};
struct EpiQ {
    static constexpr bool PERM = false, AFTER_DRAIN = false, MIDK = false;
    bf16_t* O; const PG8_LAS float* tab;
    __device__ __forceinline__ void operator()(const f32x4 (&acc)[2][2][4][2], const Unit& u, int wr, int wc, int fr, int fq) const {
        const int lc0 = wc * 32 + 4 * fq;
#pragma unroll
        for (int ai = 0; ai < 2; ++ai)
#pragma unroll
            for (int m = 0; m < 4; ++m) { const int lr = ai * HALF + wr * 64 + m * 16 + fr; const size_t off = (size_t)(u.pm * BM + lr) * 2048 + u.pn * BM + lc0;
                const float rstd = tab[256 + lr], rm = rstd * tab[lr];
#pragma unroll
                for (int bj = 0; bj < 2; ++bj)
#pragma unroll
                    for (int n = 0; n < 2; ++n) { const int lc = lc0 + bj * HALF + n * 16; const f32x4 c1 = *(const PG8_LAS f32x4*)(tab + 512 + lc), c2 = *(const PG8_LAS f32x4*)(tab + 768 + lc);
                        st_bf16x4(O + off + bj * HALF + n * 16, acc[ai][bj][m][n] * rstd - c1 * rm + c2); } }
    }
};
struct PairOrder {
    StaticOrder base; int kb2;
    __host__ __device__ __forceinline__ void init(int M, int N, int G_, int c_, int kb2_) { base.init(M, N, G_, c_); kb2 = kb2_; }
    __host__ __device__ __forceinline__ bool next(int i, Unit& u) const { if (!base.next(i >> 1, u)) return false; u.kb = (i & 1) ? kb2 : 0; return true; }
    __device__ __forceinline__ void a_ready(const Unit&) const {}
    __device__ __forceinline__ void done(const Unit&) const {}
};

template <class Epi, class Sched, bool ALIGN_EPI = false, bool SP2 = false>
__device__ __forceinline__ void gemm_phase(PG8_LAS unsigned char* lds, const Gemm g, const Sched& S, const Epi& E, const int wave_s__) {
    const int tid = opq_tid(wave_s__), wid = __builtin_amdgcn_readfirstlane(tid >> 6), lane = tid & 63, wr = wid >> 2, wc = wid & 3, fr = lane & 15, fq = lane >> 4;
    const int K = g.ld, nt = g.K / BK;
    unsigned voffA[2], voffB[2];
#pragma unroll
    for (int i = 0; i < 2; ++i) { int R, C; stage_rc(tid * 16 + i * 8192, R, C); const int Rb = Epi::PERM ? ((R & ~31) + perm32(R & 31)) : R;
        voffA[i] = (unsigned)(R * K + C) * 2u; voffB[i] = (unsigned)(Rb * K + C) * 2u; }
    const size_t kstep = (size_t)(BK * 2);
    const size_t hstep = (size_t)HALF * K * 2;
    const size_t tstep = 2 * hstep;
    const unsigned ldsw = (unsigned)wid * 1024u;
    const int aoff = lds_byte(wr * 64 + fr, fq * 8), boff = lds_byte(wc * 32 + fr, fq * 8);
#define PG8_SA(b, h) (((b) * 2 + (h)) * HTB)
#define PG8_SB(b, h) ((4 + (b) * 2 + (h)) * HTB)
#define PG8_STAGE(bufoff, gbase, voff) do { _Pragma("unroll") for (int _i = 0; _i < 2; ++_i) \
        __builtin_amdgcn_global_load_lds((const unsigned*)((const char*)(gbase) + (voff)[_i]), (PG8_LAS unsigned*)(lds + (bufoff) + ldsw + _i * 8192), 16, 0, 0); } while (0)
#define PG8_LDA(dst, b, h) do { _Pragma("unroll") for (int m = 0; m < 4; ++m) _Pragma("unroll") for (int k = 0; k < 2; ++k) dst[m][k] = *(const PG8_LAS bf16x8*)(lds + PG8_SA(b, h) + aoff + m * 2048 + k * 1024); } while (0)
#define PG8_LDB(dst, b, h) do { _Pragma("unroll") for (int n = 0; n < 2; ++n) _Pragma("unroll") for (int k = 0; k < 2; ++k) dst[n][k] = *(const PG8_LAS bf16x8*)(lds + PG8_SB(b, h) + boff + n * 2048 + k * 1024); } while (0)
#define PG8_MMA(ai, bj, At, Bt) do { __builtin_amdgcn_s_setprio(1); _Pragma("unroll") for (int m = 0; m < 4; ++m) _Pragma("unroll") for (int n = 0; n < 2; ++n) _Pragma("unroll") for (int k = 0; k < 2; ++k) \
        acc[ai][bj][m][n] = __builtin_amdgcn_mfma_f32_16x16x32_bf16(Bt[n][k], At[m][k], acc[ai][bj][m][n], 0, 0, 0); __builtin_amdgcn_s_setprio(0); } while (0)
#define PG8_WAIT_V(n) asm volatile("s_waitcnt vmcnt(" #n ")" ::: "memory")
#define PG8_WAIT_L(n) asm volatile("s_waitcnt lgkmcnt(" #n ")" ::: "memory")
#define PG8_BAR __builtin_amdgcn_s_barrier()
#define PG8_SCHED __builtin_amdgcn_sched_barrier(0)
    Unit cur, nxt; int ui = 0;
    if (!S.next(0, cur)) return;
    f32x4 acc[2][2][4][2];
#pragma unroll
    for (int a = 0; a < 2; ++a)
#pragma unroll
        for (int b = 0; b < 2; ++b)
#pragma unroll
            for (int m = 0; m < 4; ++m)
#pragma unroll
                for (int n = 0; n < 2; ++n) acc[a][b][m][n] = (f32x4){0.f, 0.f, 0.f, 0.f};
    bf16x8 At[4][2], B0[2][2], B1[2][2];
    const char* cA = (const char*)g.A + (size_t)cur.pm * tstep + cur.kb; const char* cB = (const char*)g.Bt + (size_t)cur.pn * tstep + cur.kb;
    S.a_ready(cur);
    if constexpr (SP2) {
        PG8_STAGE(PG8_SB(0, 0), cB, voffB); PG8_STAGE(PG8_SB(0, 1), cB + hstep, voffB); PG8_STAGE(PG8_SA(0, 0), cA, voffA); PG8_STAGE(PG8_SA(0, 1), cA + hstep, voffA);
        if (wr == 1) PG8_BAR;
        PG8_WAIT_V(2); PG8_BAR;
        PG8_STAGE(PG8_SB(1, 0), cB + kstep, voffB); PG8_STAGE(PG8_SA(1, 0), cA + kstep, voffA); PG8_STAGE(PG8_SB(1, 1), cB + hstep + kstep, voffB);
        PG8_WAIT_V(6); PG8_BAR;
    } else {
        PG8_STAGE(PG8_SB(0, 0), cB, voffB); PG8_STAGE(PG8_SA(0, 0), cA, voffA); PG8_STAGE(PG8_SB(0, 1), cB + hstep, voffB); PG8_STAGE(PG8_SA(0, 1), cA + hstep, voffA);
        if (wr == 1) PG8_BAR;
        PG8_WAIT_V(4); PG8_BAR;
        PG8_STAGE(PG8_SB(1, 0), cB + kstep, voffB); PG8_STAGE(PG8_SA(1, 0), cA + kstep, voffA); PG8_STAGE(PG8_SB(1, 1), cB + hstep + kstep, voffB);
        PG8_WAIT_V(6); PG8_BAR;
    }
    for (;;) {
        const bool has_next = S.next(ui + 1, nxt);
        const char* nA = has_next ? (const char*)g.A + (size_t)nxt.pm * tstep + nxt.kb : cA; const char* nB = has_next ? (const char*)g.Bt + (size_t)nxt.pn * tstep + nxt.kb : cB;
        for (int t = 0; t < nt; t += 2) {
            const bool last = (t == nt - 2);
            const char* a1 = cA + (size_t)(t + 1) * kstep;
            const char* a2 = last ? nA : cA + (size_t)(t + 2) * kstep; const char* b2 = last ? nB : cB + (size_t)(t + 2) * kstep;
            const char* a3 = a2 + kstep; const char* b3 = b2 + kstep;
            if (last && has_next) S.a_ready(nxt);
            if constexpr (SP2) {
            PG8_LDB(B0, 0, 0); PG8_LDB(B1, 0, 1); PG8_SCHED; PG8_LDA(At, 0, 0); PG8_STAGE(PG8_SA(1, 1), a1 + hstep, voffA);
            PG8_WAIT_V(8); PG8_WAIT_L(0); PG8_BAR; PG8_MMA(0, 0, At, B0); PG8_MMA(0, 1, At, B1); PG8_BAR; PG8_SCHED;
            PG8_LDA(At, 0, 1); PG8_STAGE(PG8_SB(0, 0), b2, voffB); PG8_STAGE(PG8_SB(0, 1), b2 + hstep, voffB); PG8_STAGE(PG8_SA(0, 0), a2, voffA);
            PG8_WAIT_V(8); PG8_WAIT_L(0); PG8_BAR; PG8_MMA(1, 0, At, B0); PG8_MMA(1, 1, At, B1); PG8_BAR; PG8_SCHED;
            PG8_LDB(B0, 1, 0); PG8_LDB(B1, 1, 1); PG8_SCHED; PG8_LDA(At, 1, 0); PG8_STAGE(PG8_SA(0, 1), a2 + hstep, voffA);
            PG8_WAIT_V(8); PG8_WAIT_L(0); PG8_BAR; PG8_MMA(0, 0, At, B0); PG8_MMA(0, 1, At, B1); PG8_BAR; PG8_SCHED;
            PG8_LDA(At, 1, 1); PG8_STAGE(PG8_SB(1, 0), b3, voffB); PG8_STAGE(PG8_SB(1, 1), b3 + hstep, voffB); PG8_STAGE(PG8_SA(1, 0), a3, voffA);
            PG8_WAIT_V(8); PG8_WAIT_L(0); PG8_BAR; PG8_MMA(1, 0, At, B0); PG8_MMA(1, 1, At, B1); PG8_BAR; PG8_SCHED;
            } else {
            PG8_LDB(B0, 0, 0); PG8_SCHED; PG8_LDA(At, 0, 0); PG8_STAGE(PG8_SA(1, 1), a1 + hstep, voffA);
            PG8_WAIT_L(8); PG8_BAR; PG8_WAIT_L(0); PG8_MMA(0, 0, At, B0); PG8_BAR; PG8_SCHED;
            PG8_LDB(B1, 0, 1); PG8_STAGE(PG8_SB(0, 0), b2, voffB);
            PG8_BAR; PG8_WAIT_L(0); PG8_MMA(0, 1, At, B1); PG8_BAR;
            PG8_LDA(At, 0, 1); PG8_STAGE(PG8_SA(0, 0), a2, voffA);
            PG8_BAR; PG8_WAIT_L(0); PG8_MMA(1, 0, At, B0); PG8_BAR; PG8_SCHED;
            PG8_STAGE(PG8_SB(0, 1), b2 + hstep, voffB);
            PG8_WAIT_V(6); PG8_BAR; PG8_MMA(1, 1, At, B1); PG8_BAR;
            PG8_LDB(B0, 1, 0); PG8_SCHED; PG8_LDA(At, 1, 0); PG8_STAGE(PG8_SA(0, 1), a2 + hstep, voffA);
            PG8_WAIT_L(8); PG8_BAR; PG8_WAIT_L(0); PG8_MMA(0, 0, At, B0); PG8_BAR; PG8_SCHED;
            PG8_LDB(B1, 1, 1); PG8_STAGE(PG8_SB(1, 0), b3, voffB);
            PG8_BAR; PG8_WAIT_L(0); PG8_MMA(0, 1, At, B1); PG8_BAR;
            PG8_LDA(At, 1, 1); PG8_STAGE(PG8_SA(1, 0), a3, voffA);
            PG8_BAR; PG8_WAIT_L(0); PG8_MMA(1, 0, At, B0); PG8_BAR; PG8_SCHED;
            PG8_STAGE(PG8_SB(1, 1), b3 + hstep, voffB);
            PG8_WAIT_V(6); PG8_BAR; PG8_MMA(1, 1, At, B1); PG8_BAR;
            }
        }
        if constexpr (ALIGN_EPI) { if (wr == 0) PG8_BAR; }
        bool keep_acc_ = false;
        if constexpr (Epi::MIDK) { keep_acc_ = (cur.kb == 0); if (keep_acc_) E.mid(acc, cur, wr, wc, fr, fq); else { E(acc, cur, wr, wc, fr, fq); S.done(cur); } }
        else if constexpr (!Epi::AFTER_DRAIN) { E(acc, cur, wr, wc, fr, fq); S.done(cur); }
        if (!has_next) break;
        if (!keep_acc_) {
#pragma unroll
        for (int a = 0; a < 2; ++a)
#pragma unroll
            for (int b = 0; b < 2; ++b)
#pragma unroll
                for (int m = 0; m < 4; ++m)
#pragma unroll
                    for (int n = 0; n < 2; ++n) acc[a][b][m][n] = (f32x4){0.f, 0.f, 0.f, 0.f};
        }
        cur = nxt; cA = nA; cB = nB; ++ui;
        if constexpr (ALIGN_EPI) { if (wr == 1) PG8_BAR; }
    }
    PG8_WAIT_V(0);
    if constexpr (!ALIGN_EPI) { if (wr == 0) PG8_BAR; }
    PG8_BAR;
    if constexpr (Epi::AFTER_DRAIN) { E.fused(acc, cur, wr, wc, fr, fq, lds, wid, lane); S.done(cur); }
#undef PG8_SA
#undef PG8_SB
#undef PG8_STAGE
#undef PG8_LDA
#undef PG8_LDB
#undef PG8_MMA
#undef PG8_WAIT_V
#undef PG8_WAIT_L
#undef PG8_BAR
#undef PG8_SCHED
}
}
namespace att {
constexpr int D = 128; constexpr float THR = 8.f; constexpr bool WSKIP = false;
constexpr float SCALE = 0.08838834764831845f;
constexpr int NW = 8, QBLK = 32, KVBLK = 64, QB = NW * QBLK;
constexpr int SHM_V = KVBLK * D * 2, SHM_K = KVBLK * D * 2;
constexpr int LDS_BYTES = 2 * SHM_V + 2 * SHM_K + NW * 64 * 4;

typedef short bf16x8 __attribute__((ext_vector_type(8)));
typedef short s16x4 __attribute__((ext_vector_type(4)));
typedef float f32x16 __attribute__((ext_vector_type(16)));
typedef float f32x4 __attribute__((ext_vector_type(4)));
typedef unsigned u32x4 __attribute__((ext_vector_type(4)));
template <class A, class Bt> struct same_t { static constexpr bool v = false; };
template <class A> struct same_t<A, A> { static constexpr bool v = true; };

#define KSWZ(row, colB) ((row) * 256 + ((colB) ^ (((row) & 7) << 4)))
#define SBAR() __builtin_amdgcn_sched_barrier(0)
__device__ __forceinline__ int v_st(int k, int c) { const int kk = (k & ~0xC) | ((k & 4) << 1) | ((k & 8) >> 1); return ((kk >> 3) * 4 + (c >> 5)) * 512 + ((kk & 7) * 32 + (c & 31)) * 2; }
__device__ __forceinline__ int v_rd_base(int lane) { return ((lane & 3) << 3) | (((lane >> 2) & 3) << 6) | (((lane >> 4) & 1) << 5) | (((lane >> 5) & 1) << 8); }
constexpr int v_rd_off(int d0, int ks, int half) { return d0 * 512 + ks * 4096 + half * 2048; }
__device__ __forceinline__ int crow(int r, int hi) { return (r & 3) + 8 * (r >> 2) + 4 * hi; }
__device__ __forceinline__ unsigned cvtpk(float lo, float hi) {
    unsigned r; asm volatile("v_cvt_pk_bf16_f32 %0, %1, %2" : "=v"(r) : "v"(lo), "v"(hi)); return r;
}
__device__ __forceinline__ bf16x8 pack8(f32x4 a, f32x4 b) {
    u32x4 w = {cvtpk(a[0], a[1]), cvtpk(a[2], a[3]), cvtpk(b[0], b[1]), cvtpk(b[2], b[3])};
    return *reinterpret_cast<bf16x8*>(&w);
}
template <class T> __device__ __forceinline__ bf16x8 load8(const T* p) {
    if constexpr (same_t<T, float>::v) { return pack8(*(const f32x4*)p, *(const f32x4*)(p + 4)); }
    else { return *reinterpret_cast<const bf16x8*>(p); }
}
__device__ __forceinline__ void mask_tile(f32x16& p0, f32x16& p1, int dq, unsigned W) {
    const float NEG = -__builtin_inff();
#pragma unroll
    for (int r = 0; r < 16; ++r) {
        const int c = (r & 3) + 8 * (r >> 2);
        if ((unsigned)(dq - c) >= W) p0[r] = NEG;
        if ((unsigned)(dq - c - 32) >= W) p1[r] = NEG;
    }
}
__device__ __forceinline__ void partialSM(f32x16& p0, f32x16& p1, float& m_reg, float& mn, float& alpha) {
    float pmax = p0[0]; for (int r = 1; r < 16; ++r) pmax = fmaxf(pmax, p0[r]); for (int r = 0; r < 16; ++r) pmax = fmaxf(pmax, p1[r]);
    { auto rr = __builtin_amdgcn_permlane32_swap(__float_as_uint(pmax), __float_as_uint(pmax), false, false);
      pmax = fmaxf(__uint_as_float(rr[0]), __uint_as_float(rr[1])); }
    constexpr float C2 = 1.4426950408889634f * SCALE;
    if (__builtin_expect(__all((pmax - m_reg) * SCALE <= THR), 1)) { mn = m_reg; alpha = 1.f; }
    else { mn = fmaxf(m_reg, pmax); alpha = __builtin_amdgcn_exp2f((m_reg - mn) * C2); m_reg = mn; }
    const float mnL = -mn * C2;
    for (int r = 0; r < 16; ++r) p0[r] = fmaf(p0[r], C2, mnL); for (int r = 0; r < 16; ++r) p1[r] = fmaf(p1[r], C2, mnL);
    for (int r = 0; r < 16; ++r) p0[r] = __builtin_amdgcn_exp2f(p0[r]);
}
__device__ __forceinline__ void finishSM(f32x16& p0, f32x16& p1, float alpha, float& l_reg, bf16x8& pa0, bf16x8& pa1, bf16x8& pa2, bf16x8& pa3) {
    for (int r = 0; r < 16; ++r) p1[r] = __builtin_amdgcn_exp2f(p1[r]);
    float ps = 0; for (int r = 0; r < 16; ++r) ps += p0[r]; for (int r = 0; r < 16; ++r) ps += p1[r];
    { auto rr = __builtin_amdgcn_permlane32_swap(__float_as_uint(ps), __float_as_uint(ps), false, false);
      ps = __uint_as_float(rr[0]) + __uint_as_float(rr[1]); }
    l_reg = l_reg * alpha + ps;
#define PK4(P, B_, OUT) do { unsigned a0 = cvtpk(P[B_+0], P[B_+1]), a1 = cvtpk(P[B_+2], P[B_+3]);                          \
        unsigned b0 = cvtpk(P[B_+4], P[B_+5]), b1 = cvtpk(P[B_+6], P[B_+7]);                                             \
        auto r0 = __builtin_amdgcn_permlane32_swap(a0, b0, false, false); auto r1 = __builtin_amdgcn_permlane32_swap(a1, b1, false, false); \
        u32x4 w = {r0[0], r1[0], r0[1], r1[1]}; OUT = *reinterpret_cast<bf16x8*>(&w); } while (0)
    PK4(p0, 0, pa0); PK4(p0, 8, pa1); PK4(p1, 0, pa2); PK4(p1, 8, pa3);
#undef PK4
}
template <int KB, bool SK>
__device__ __forceinline__ void qkt(f32x16& p0, f32x16& p1, const char* K_lds, int r32, int hi, const bf16x8* qr, bool act) {
    if (SK && !act) { const float NEG = -__builtin_inff();
#pragma unroll
        for (int r = 0; r < 16; ++r) { p0[r] = NEG; p1[r] = NEG; } return; }
    p0 = f32x16{}; p1 = f32x16{};
    const char* kb[4];
#pragma unroll
    for (int dd = 0; dd < 4; ++dd) kb[dd] = K_lds + KB * SHM_K + KSWZ(r32, (dd * 16 + hi * 8) * 2);
#pragma unroll
    for (int d0 = 0; d0 < 8; ++d0) { const char* a = kb[d0 & 3] + (d0 >> 2) * 128;
        bf16x8 b0 = *reinterpret_cast<const bf16x8*>(a);
        bf16x8 b1 = *reinterpret_cast<const bf16x8*>(a + 32 * 256);
        p0 = __builtin_amdgcn_mfma_f32_32x32x16_bf16(b0, qr[d0], p0, 0, 0, 0);
        p1 = __builtin_amdgcn_mfma_f32_32x32x16_bf16(b1, qr[d0], p1, 0, 0, 0); }
}
template <int VB, bool SK>
__device__ __forceinline__ void pv_tile(f32x16* o, int vb0, bf16x8 pa0, bf16x8 pa1, bf16x8 pa2, bf16x8 pa3, bool act) {
    if (SK && !act) return;
#define TRRD(dst, off) asm volatile("ds_read_b64_tr_b16 %0, %1 offset:%2" : "=&v"(dst) : "v"(vb0), "i"(off) : "memory")
#define PV_D0(d0) do { s16x4 l0, l1, l2, l3, h0, h1, h2, h3; constexpr int b_ = VB * SHM_V + v_rd_off(d0, 0, 0);     \
        TRRD(l0, b_); TRRD(h0, b_ + 2048); TRRD(l1, b_ + 4096); TRRD(h1, b_ + 6144); TRRD(l2, b_ + 8192); TRRD(h2, b_ + 10240); TRRD(l3, b_ + 12288); TRRD(h3, b_ + 14336); \
        asm volatile("s_waitcnt lgkmcnt(0)" ::: "memory"); SBAR();                 \
        o[d0] = __builtin_amdgcn_mfma_f32_32x32x16_bf16(pa0, (bf16x8){l0[0], l0[1], l0[2], l0[3], h0[0], h0[1], h0[2], h0[3]}, o[d0], 0, 0, 0);   \
        o[d0] = __builtin_amdgcn_mfma_f32_32x32x16_bf16(pa1, (bf16x8){l1[0], l1[1], l1[2], l1[3], h1[0], h1[1], h1[2], h1[3]}, o[d0], 0, 0, 0);   \
        o[d0] = __builtin_amdgcn_mfma_f32_32x32x16_bf16(pa2, (bf16x8){l2[0], l2[1], l2[2], l2[3], h2[0], h2[1], h2[2], h2[3]}, o[d0], 0, 0, 0);   \
        o[d0] = __builtin_amdgcn_mfma_f32_32x32x16_bf16(pa3, (bf16x8){l3[0], l3[1], l3[2], l3[3], h3[0], h3[1], h3[2], h3[3]}, o[d0], 0, 0, 0); } while (0)
    PV_D0(0); PV_D0(1); PV_D0(2); PV_D0(3);
#undef PV_D0
#undef TRRD
}
template <class TIn, class TOut> struct BlockRef { const TIn* Q; const TIn* K; const TIn* V; TOut* O; int P0; int ostride; int moba; const float* kmean; };
template <class TIn> struct Seam {
    bf16x8 qr[8];
    bf16x8 st_v0, st_v1, st_k0, st_k1; f32x4 sf0, sf1, sf2, sf3;
    f32x4 tq[16];
};
__device__ __forceinline__ int swa_jlo(int P0, int W) { const int lowk = P0 - W + 1; return lowk > 0 ? lowk / KVBLK : 0; }
#define ROW(p, k0, rr) ((p) + (size_t)((k0) + (rr)) * D + sc)
#define VMW() asm volatile("s_waitcnt vmcnt(0)" ::: "memory")
#define VMWN(n) asm volatile("s_waitcnt vmcnt(%0)" :: "i"(n) : "memory")
#define SLOAD_H(Kp, Vp, k0) do { S.st_v0 = load8<TIn>(ROW(Vp, k0, sr)); S.st_v1 = load8<TIn>(ROW(Vp, k0, 32 + sr));              \
                         S.st_k0 = load8<TIn>(ROW(Kp, k0, sr)); S.st_k1 = load8<TIn>(ROW(Kp, k0, 32 + sr)); } while (0)
#define SWRITE_HK(bf) do { *(bf16x8*)(K_lds + (bf) * SHM_K + kws) = S.st_k0; *(bf16x8*)(K_lds + (bf) * SHM_K + kws + 32 * 256) = S.st_k1; } while (0)
#define SWRITE_HV(bf) do { *(bf16x8*)(V_lds + (bf) * SHM_V + vst0) = S.st_v0; *(bf16x8*)(V_lds + (bf) * SHM_V + vst1) = S.st_v1; } while (0)
#define SWRITE_H(bf) do { SWRITE_HV(bf); SWRITE_HK(bf); } while (0)
#define SLOAD_F(p, k0) do { S.sf0 = *(const f32x4*)ROW(p, k0, sr); S.sf1 = *(const f32x4*)(ROW(p, k0, sr) + 4);                \
                            S.sf2 = *(const f32x4*)ROW(p, k0, 32 + sr); S.sf3 = *(const f32x4*)(ROW(p, k0, 32 + sr) + 4); } while (0)
#define SWRITE_KF(bf) do { *(bf16x8*)(K_lds + (bf) * SHM_K + kws) = pack8(S.sf0, S.sf1); *(bf16x8*)(K_lds + (bf) * SHM_K + kws + 32 * 256) = pack8(S.sf2, S.sf3); } while (0)
#define SWRITE_VF(bf) do { *(bf16x8*)(V_lds + (bf) * SHM_V + vst0) = pack8(S.sf0, S.sf1); *(bf16x8*)(V_lds + (bf) * SHM_V + vst1) = pack8(S.sf2, S.sf3); } while (0)
template <class TIn, class TOut>
__device__ __forceinline__ void causal_swa_prime(const BlockRef<TIn, TOut>& cur, int W, char* lds, Seam<TIn>& S, const int wave_s__) {
    constexpr bool F32 = same_t<TIn, float>::v;
    const int tid = opq_tid(wave_s__), wid = __builtin_amdgcn_readfirstlane(tid >> 6), lane = tid & 63, r32 = lane & 31, hi = lane >> 5;
    const int sr = tid >> 4, sc = (tid & 15) * 8, kws = KSWZ(sr, sc * 2); char* K_lds = lds + 2 * SHM_V;
    const int kb0 = swa_jlo(cur.P0, W) * KVBLK;
    for (int d0 = 0; d0 < 8; ++d0) S.qr[d0] = load8<TIn>(cur.Q + (size_t)(wid * QBLK + r32) * D + d0 * 16 + hi * 8);
    if constexpr (F32) { SLOAD_F((const float*)cur.K, kb0); VMW(); SWRITE_KF(0); SBAR(); SLOAD_F((const float*)cur.V, kb0); }
    else { SLOAD_H(cur.K, cur.V, kb0); VMW(); SWRITE_HK(0); }
    __syncthreads();
}
template <class TIn, class TOut>
__device__ __forceinline__ void causal_swa_block(const BlockRef<TIn, TOut>& cur, const BlockRef<TIn, TOut>& nxt, int skv, int W, char* lds, Seam<TIn>& S, const int wave_s__) {
    constexpr bool F32 = same_t<TIn, float>::v;
    const int tid = opq_tid(wave_s__), wid = __builtin_amdgcn_readfirstlane(tid >> 6), lane = tid & 63, r32 = lane & 31, hi = lane >> 5;
    const int j_lo = swa_jlo(cur.P0, W);
    int j_hi = (cur.P0 + QB - 1) / KVBLK + 1; if (j_hi > skv / KVBLK) j_hi = skv / KVBLK;
    const int NT = j_hi - j_lo;
    const int kbn = swa_jlo(nxt.P0, W) * KVBLK;
    const int qlo = cur.P0 + wid * QBLK, qm = qlo + r32 - 4 * hi;
    char* V_lds = lds; char* K_lds = lds + 2 * SHM_V;
    float* ws = (float*)(lds + 2 * SHM_V + 2 * SHM_K) + wid * 64; float* li_l = ws, * al_l = ws + 32;
    float m_reg = -1e30f, l_reg = 0; f32x16 o[4] = {};
    const int sr = tid >> 4, sc = (tid & 15) * 8, vst0 = v_st(sr, sc), vst1 = v_st(32 + sr, sc), kws = KSWZ(sr, sc * 2);
    const int vb0 = (int)(uintptr_t)V_lds + v_rd_base(lane);
    const TIn* Kh = cur.K; const TIn* Vh = cur.V;
    const int own = cur.P0 >> 8; const int moba = cur.moba;
    unsigned selmask = 0xFFFFFFFFu;
    if (moba) {
        float qf[64];
#pragma unroll
        for (int d0 = 0; d0 < 8; ++d0)
#pragma unroll
            for (int j = 0; j < 8; ++j) qf[d0 * 8 + j] = __uint_as_float(((unsigned)(unsigned short)S.qr[d0][j]) << 16);
        float g1 = -3e38f, g2 = -3e38f, g3 = -3e38f; int i1 = -1, i2 = -1, i3 = -1;
        for (int n = 0; n < own; ++n) {
            const float* km = cur.kmean + n * 128 + hi * 8;
            float a0 = 0.f, a1 = 0.f;
#pragma unroll
            for (int d0 = 0; d0 < 8; ++d0) { const f32x4 k0 = *(const f32x4*)(km + d0 * 16), k1 = *(const f32x4*)(km + d0 * 16 + 4);
                a0 = fmaf(qf[d0 * 8 + 0], k0[0], a0); a0 = fmaf(qf[d0 * 8 + 1], k0[1], a0); a0 = fmaf(qf[d0 * 8 + 2], k0[2], a0); a0 = fmaf(qf[d0 * 8 + 3], k0[3], a0);
                a1 = fmaf(qf[d0 * 8 + 4], k1[0], a1); a1 = fmaf(qf[d0 * 8 + 5], k1[1], a1); a1 = fmaf(qf[d0 * 8 + 6], k1[2], a1); a1 = fmaf(qf[d0 * 8 + 7], k1[3], a1); }
            float a = a0 + a1; a += __shfl_xor(a, 32);
            const bool b1 = a > g1, b2 = a > g2, b3 = a > g3;
            g3 = b2 ? g2 : (b3 ? a : g3); i3 = b2 ? i2 : (b3 ? n : i3);
            g2 = b1 ? g1 : (b2 ? a : g2); i2 = b1 ? i1 : (b2 ? n : i2);
            g1 = b1 ? a : g1; i1 = b1 ? n : i1;
        }
        selmask = 0u; if (i1 >= 0) selmask |= 1u << i1; if (i2 >= 0) selmask |= 1u << i2; if (i3 >= 0) selmask |= 1u << i3;
    }
#define RESC(a) do { if (__any((a) < 1.f)) { if (hi == 0) al_l[r32] = (a); asm volatile("s_waitcnt lgkmcnt(0)" ::: "memory");              \
                     for (int d_ = 0; d_ < 4; ++d_) for (int r = 0; r < 16; ++r) o[d_][r] *= al_l[crow(r, hi)]; } } while (0)
#define KBASE(t) ((j_lo + (t)) * KVBLK)
#define ACT(t) (KBASE(t) <= qlo + QBLK - 1 && KBASE(t) + KVBLK - 1 >= qlo - W + 1)
#define MASKT(P0_, P1_, t) do { const int kb_ = KBASE(t); if ((!SK || ACT(t)) && (kb_ + KVBLK - 1 > qlo || kb_ <= qlo + QBLK - 1 - W)) mask_tile(P0_, P1_, qm - kb_, (unsigned)W); \
        if (moba && (kb_ >> 8) < own) { const bool keep_ = (selmask >> (kb_ >> 8)) & 1u; const float NEG_ = -__builtin_inff(); \
            _Pragma("unroll") for (int r_ = 0; r_ < 16; ++r_) { P0_[r_] = keep_ ? P0_[r_] : NEG_; P1_[r_] = keep_ ? P1_[r_] : NEG_; } } } while (0)
    constexpr int NQL = F32 ? 16 : 8;
    constexpr bool SK = WSKIP && !F32;
#define SEAM_K0() do { VMWN(NQL); if constexpr (F32) { SWRITE_KF(0); SBAR(); SLOAD_F((const float*)nxt.V, kbn); } else { SWRITE_HK(0); } SBAR(); } while (0)
    f32x16 pA0, pA1, pB0, pB1; float mnA, mnB, alA, alB; bf16x8 pa0, pa1, pa2, pa3;
    if constexpr (F32) { VMW(); SWRITE_VF(0); SBAR(); } else { SWRITE_HV(0); SBAR(); }
    if (NT > 1) { if constexpr (F32) SLOAD_F((const float*)Kh, KBASE(1)); else SLOAD_H(Kh, Vh, KBASE(1)); }
    SBAR(); qkt<0, SK>(pA0, pA1, K_lds, r32, hi, S.qr, ACT(0));
    if constexpr (F32) { if (NT > 1) { VMW(); SWRITE_KF(1); SBAR(); SLOAD_F((const float*)Vh, KBASE(1)); } }
    MASKT(pA0, pA1, 0); partialSM(pA0, pA1, m_reg, mnA, alA);
    if (NT > 1) { VMW(); if constexpr (F32) { SWRITE_VF(1); SBAR(); if (NT > 2) SLOAD_F((const float*)Kh, KBASE(2)); } else SWRITE_H(1); }
    __syncthreads();
#define HALF_STEP(PX0, PX1, mnX, alX, PY0, PY1, alY, t, KB, VB, SB) do {                                                      \
        SBAR(); qkt<KB, SK>(PX0, PX1, K_lds, r32, hi, S.qr, ACT(t));                                             \
        finishSM(PY0, PY1, alY, l_reg, pa0, pa1, pa2, pa3); SBAR();                                                           \
        if ((t) + 1 < NT) { if constexpr (F32) { VMW(); SWRITE_KF(SB); SBAR(); SLOAD_F((const float*)Vh, KBASE((t) + 1)); }  \
                            else { SLOAD_H(Kh, Vh, KBASE((t) + 1)); } SBAR(); }                                               \
        pv_tile<VB, SK>(o, vb0, pa0, pa1, pa2, pa3, ACT((t) - 1)); MASKT(PX0, PX1, (t)); partialSM(PX0, PX1, m_reg, mnX, alX);                                        \
        __syncthreads();                                                                                                      \
        if ((t) + 1 < NT) { VMW(); if constexpr (F32) { SWRITE_VF(SB); SBAR(); if ((t) + 2 < NT) SLOAD_F((const float*)Kh, KBASE((t) + 2)); } \
                            else { SWRITE_H(SB); } }                                                                          \
        RESC(alX); __syncthreads(); } while (0)
    for (int t = 1; t + 1 < NT; t += 2) {
        HALF_STEP(pB0, pB1, mnB, alB, pA0, pA1, alA, t, 1, 0, 0);
        HALF_STEP(pA0, pA1, mnA, alA, pB0, pB1, alB, t + 1, 0, 1, 1);
    }
    const bool even = (NT & 1) == 0;
    if (even) { SBAR(); qkt<1, SK>(pB0, pB1, K_lds, r32, hi, S.qr, ACT(NT - 1)); SBAR(); }
#define QROW(e) (nxt.Q + (size_t)(wid * QBLK + r32) * D + ((e) >> 1) * 16 + hi * 8 + ((e) & 1) * 4)
    if constexpr (F32) { SLOAD_F((const float*)nxt.K, kbn); SBAR();
#pragma unroll
        for (int e = 0; e < 8; ++e) S.tq[e] = *(const f32x4*)QROW(e); }
    else { SLOAD_H(nxt.K, nxt.V, kbn); SBAR();
#pragma unroll
        for (int d0 = 0; d0 < 8; ++d0) S.qr[d0] = load8<TIn>(nxt.Q + (size_t)(wid * QBLK + r32) * D + d0 * 16 + hi * 8); }
    SBAR();
    finishSM(pA0, pA1, alA, l_reg, pa0, pa1, pa2, pa3); SBAR();
    if constexpr (F32) {
#pragma unroll
        for (int e = 8; e < 16; ++e) S.tq[e] = *(const f32x4*)QROW(e); SBAR(); }
#undef QROW
    pv_tile<0, SK>(o, vb0, pa0, pa1, pa2, pa3, ACT(even ? NT - 2 : NT - 1));
    if (even) { MASKT(pB0, pB1, NT - 1); partialSM(pB0, pB1, m_reg, mnB, alB); __syncthreads(); RESC(alB);
        finishSM(pB0, pB1, alB, l_reg, pa0, pa1, pa2, pa3); SBAR(); pv_tile<1, SK>(o, vb0, pa0, pa1, pa2, pa3, ACT(NT - 1)); }
    SBAR(); SEAM_K0();
    if (hi == 0) li_l[r32] = l_reg; asm volatile("s_waitcnt lgkmcnt(0)" ::: "memory");
    float rli[16];
#pragma unroll
    for (int r = 0; r < 16; ++r) rli[r] = __builtin_amdgcn_rcpf(li_l[crow(r, hi)]);
    const int ostr = cur.ostride; TOut* Ow = cur.O + (size_t)(wid * QBLK) * ostr;
#pragma unroll
    for (int r = 0; r < 16; ++r) { const int orow = crow(r, hi);
#pragma unroll
        for (int d0 = 0; d0 < 4; ++d0) { const float v = o[d0][r] * rli[r];
            if constexpr (same_t<TOut, float>::v) { Ow[(size_t)orow * ostr + d0 * 32 + r32] = v; }
            else { const float vn = __shfl_xor(v, 1);
                   if ((r32 & 1) == 0) *(unsigned*)(Ow + (size_t)orow * ostr + d0 * 32 + r32) = cvtpk(v, vn); } } }
    if constexpr (F32) {
#pragma unroll
        for (int d0 = 0; d0 < 8; ++d0) S.qr[d0] = pack8(S.tq[2 * d0], S.tq[2 * d0 + 1]); }
    __syncthreads();
#undef RESC
#undef KBASE
#undef ACT
#undef MASKT
#undef SEAM_K0
#undef HALF_STEP
}
#undef ROW
#undef VMW
#undef VMWN
#undef SLOAD_H
#undef SWRITE_HK
#undef SWRITE_HV
#undef SWRITE_H
#undef SLOAD_F
#undef SWRITE_KF
#undef SWRITE_VF

}
#define GAS __attribute__((address_space(1)))
#define LAS __attribute__((address_space(3)))
typedef unsigned short bf16;
typedef unsigned v4u __attribute__((ext_vector_type(4)));
typedef float f32x4 __attribute__((ext_vector_type(4)));
typedef short bf16x8 __attribute__((ext_vector_type(8)));
typedef GAS unsigned gu32;
typedef GAS unsigned long long gu64;
#define RLX_AGENT __ATOMIC_RELAXED, __HIP_MEMORY_SCOPE_AGENT
#define LDS_WAIT() asm volatile("s_waitcnt lgkmcnt(0)" ::: "memory")
#define VM_WAIT() asm volatile("s_waitcnt vmcnt(0)" ::: "memory")
__device__ __forceinline__ unsigned long long rt() { return __builtin_amdgcn_s_memrealtime(); }
__device__ __forceinline__ unsigned f2bf(float f) { unsigned u = __builtin_bit_cast(unsigned, f); return (u + 0x7fffu + ((u >> 16) & 1u)) >> 16; }
__device__ __forceinline__ unsigned pk2(float lo, float hi) { return f2bf(lo) | (f2bf(hi) << 16); }

#define XB_TMO      128
#define XB_XCNT(j)  (256  + 64 * (j))
#define XB_XSUB(j)  (1280 + 64 * (j))
#define XB_XGEN(j)  (2304 + 64 * (j))
#define XB_TOP      3328
#define XB_TOPGEN   3392
#define XCD_BAR_WORDS 3456
#define XB_SPIN_CAP (1u << 18)

__device__ __forceinline__ unsigned xb_ld(unsigned* p)              { return __hip_atomic_load(p, __ATOMIC_RELAXED, __HIP_MEMORY_SCOPE_AGENT); }
__device__ __forceinline__ unsigned xb_add(unsigned* p, unsigned v) { return __hip_atomic_fetch_add(p, v, __ATOMIC_RELAXED, __HIP_MEMORY_SCOPE_AGENT); }
__device__ __forceinline__ unsigned xb_xcc_id() { return (unsigned)__builtin_amdgcn_s_getreg((3 << 11) | 20) & 0xFu; }
#define XB_SPIN(cond, bar) do { unsigned _sp = 0; while (cond) { __builtin_amdgcn_s_sleep(1); \
    if ((++_sp & 255u) == 0u) { if (xb_ld(&(bar)[XB_TMO])) break; if (_sp > XB_SPIN_CAP) { atomicAdd(&(bar)[XB_TMO], 1u); break; } } } } while (0)

struct XcdBarrier {
    unsigned* bar; unsigned x; bool lead;
    volatile LAS unsigned* st;
};

__device__ __forceinline__ XcdBarrier xcd_barrier_post(unsigned* bar, volatile LAS unsigned* st) {
    XcdBarrier b; b.bar = bar; b.x = xb_xcc_id(); b.st = st;
    if (threadIdx.x == 0) (void)xb_add(&bar[XB_XCNT(b.x)], 1u);
    return b;
}
__device__ __forceinline__ void xcd_barrier_complete(unsigned* bar, unsigned x, unsigned& nloc, unsigned& nx) {
    const unsigned G = gridDim.x * gridDim.y * gridDim.z;
    unsigned sum, cnt, mine, sp = 0u;
    for (;;) {
        sum = 0u; cnt = 0u; mine = 0u;
#pragma unroll
        for (unsigned j = 0; j < 16; ++j) { const unsigned c = xb_ld(&bar[XB_XCNT(j)]); sum += c; cnt += (c > 0u) ? 1u : 0u; mine = (j == x) ? c : mine; }
        if (sum == G) break;
        __builtin_amdgcn_s_sleep(1);
        if ((++sp & 255u) == 0u) { if (xb_ld(&bar[XB_TMO])) break; if (sp > XB_SPIN_CAP) { atomicAdd(&bar[XB_TMO], 1u); break; } }
    }
    nloc = mine > 0u ? mine : 1u; nx = cnt > 0u ? cnt : 1u;
}

__device__ __forceinline__ void xcd_barrier(const XcdBarrier& b) {
    asm volatile("s_waitcnt vmcnt(0)" ::: "memory");
    __syncthreads();
    if (b.lead) {
        unsigned* bar = b.bar;
        __builtin_amdgcn_s_waitcnt(0);
        unsigned nloc = b.st[0], nx = b.st[1];
        if (nloc == 0u) { xcd_barrier_complete(bar, b.x, nloc, nx); b.st[0] = nloc; b.st[1] = nx; }
        const unsigned old = xb_add(&bar[XB_XSUB(b.x)], 1u);
        const unsigned gen = old / nloc;
        if (old + 1u == (gen + 1u) * nloc) {
            __builtin_amdgcn_fence(__ATOMIC_RELEASE, "agent");
            asm volatile("s_waitcnt vmcnt(0)" ::: "memory");
            const unsigned og = xb_add(&bar[XB_TOP], 1u);
            const unsigned tg = og / nx;
            if (og + 1u == (tg + 1u) * nx) xb_add(&bar[XB_TOPGEN], 1u);
            else XB_SPIN(xb_ld(&bar[XB_TOPGEN]) == tg, bar);
            __builtin_amdgcn_fence(__ATOMIC_ACQUIRE, "agent");
            xb_add(&bar[XB_XGEN(b.x)], 1u);
            asm volatile("s_waitcnt vmcnt(0)" ::: "memory");
        } else {
            XB_SPIN(xb_ld(&bar[XB_XGEN(b.x)]) == gen, bar);
            __builtin_amdgcn_fence(__ATOMIC_ACQUIRE, "agent");
            asm volatile("s_waitcnt vmcnt(0)" ::: "memory");
        }
    }
    __syncthreads();
}

constexpr int NWAVES = 8;
constexpr int BATCH = 2, SEQ = 4096, T = BATCH * SEQ, DM = 2048, DEPTH = 2;
constexpr int IN_COLS = 10240, NEXP = 16384;
constexpr float LN_EPS = 1e-5f, RMS_EPS = 1e-5f;
constexpr float DN_ALPHA = 1.4142135623730951f;

constexpr size_t MiB = 1u << 20;
constexpr size_t WS_CTL = 0, CTL_ZERO_BYTES = 1 * MiB;
constexpr size_t WS_ROPE = 1 * MiB;
constexpr size_t WS_KMEAN = 1 * MiB + 512 * 1024;
constexpr size_t WS_SUBK = 2 * MiB;
constexpr size_t WS_WIN = 4 * MiB;
constexpr size_t WS_WBR = 84 * MiB;
constexpr size_t WS_WOUT = 100 * MiB, WS_WQ = 116 * MiB;
constexpr size_t WS_PU8 = 132 * MiB, WS_PV8 = 132 * MiB + (size_t)2 * 16384 * 1536;
constexpr size_t WS_RSP = 230 * MiB;
constexpr size_t WS_C1P = 236 * MiB, WS_C2P = 237 * MiB;
constexpr size_t WS_SCL = 260 * MiB;
constexpr size_t WS_QKV = 388 * MiB;
constexpr size_t WS_GATES = 484 * MiB;
constexpr size_t WS_YMD = 548 * MiB;
constexpr size_t WS_QP = 548 * MiB;
constexpr size_t WS_OD = 580 * MiB;
constexpr size_t WS_X1 = 580 * MiB;
constexpr size_t WS_MF = 644 * MiB;
constexpr size_t WS_MB = 708 * MiB;
constexpr size_t WS_X1B = 740 * MiB;
constexpr size_t WS_IDX = 772 * MiB, WS_GATE = 776 * MiB;
constexpr size_t WS_X2 = 780 * MiB;
constexpr size_t WS_XB = 844 * MiB;
constexpr size_t WS_END = 876 * MiB;

constexpr int CW_ATTQ = 64;
constexpr int CW_BAR = 4096;


constexpr int RING_OFF = 0, RING_BYTES = 131072;
constexpr int PEER_TC_OFF = RING_BYTES;
constexpr int LDSCTL_OFF = RING_BYTES + 16384, MISC_OFF = LDSCTL_OFF + 320;
constexpr int PEER_TC16_OFF = LDSCTL_OFF + 4096;
constexpr int LDS_BYTES = PEER_TC16_OFF + 8192;

struct Frame {
    LAS unsigned char* lds;
    volatile LAS unsigned* MISC;
    gu32* ctl;
    unsigned char* ws;
    int tid, lane, wave;
    int vcu, G;
    const float* in[15];
    float* out;
};
extern __shared__ __attribute__((aligned(16))) unsigned char lds_all[];
constexpr int CTX_OFF = MISC_OFF + 128;
__device__ __forceinline__ unsigned long long ctx_ld(int i) {
    volatile LAS unsigned* p = (volatile LAS unsigned*)((LAS unsigned char*)lds_all + CTX_OFF + 8 * i);
    const unsigned lo = __builtin_amdgcn_readfirstlane(p[0]), hi = __builtin_amdgcn_readfirstlane(p[1]);
    return ((unsigned long long)hi << 32) | lo;
}
__device__ __forceinline__ void mk_frame(Frame& F, const int wave_s__) {
    F.lds = (LAS unsigned char*)lds_all;
    F.MISC = (volatile LAS unsigned*)(F.lds + MISC_OFF);
    F.tid = opq_tid(wave_s__); F.lane = F.tid & 63; F.wave = __builtin_amdgcn_readfirstlane(F.tid >> 6);
    F.G = gridDim.x; { const int bx = blockIdx.x; F.vcu = (F.G % 8 == 0) ? (bx % 8) * (F.G / 8) + bx / 8 : bx; }
#pragma unroll
    for (int i = 0; i < 15; ++i) F.in[i] = (const float*)ctx_ld(i);
    F.out = (float*)ctx_ld(15); F.ws = (unsigned char*)ctx_ld(16); F.ctl = (gu32*)(F.ws + WS_CTL);
}
__device__ __forceinline__ float wave_sum(float v) {
#pragma unroll
    for (int o = 1; o < 64; o <<= 1) v += __shfl_xor(v, o);
    return v;
}
__device__ __forceinline__ float bf2f(unsigned short h) { return __uint_as_float(((unsigned)h) << 16); }
__device__ __forceinline__ float bflo(unsigned w) { return __uint_as_float(w << 16); }
__device__ __forceinline__ float bfhi(unsigned w) { return __uint_as_float(w & 0xffff0000u); }

template <bool NTS>
__device__ __forceinline__ void p0_transpose_item(const float* W, int K, int N, bf16* WT, int ldk, int koff, LAS float* scr, int item, int lane) {
    const int nblk = N / 32, kb = item / nblk, nb = item % nblk, k0 = 64 * kb, n0 = 32 * nb;
    float tv[32];
#pragma unroll
    for (int i = 0; i < 32; ++i) { const int kk = 2 * i + (lane >> 5); tv[i] = __builtin_nontemporal_load((const GAS float*)&W[(size_t)(k0 + kk) * N + n0 + (lane & 31)]); }
#pragma unroll
    for (int i = 0; i < 32; ++i) { const int kk = 2 * i + (lane >> 5); scr[kk * 33 + (lane & 31)] = tv[i]; }
    LDS_WAIT(); asm volatile("" ::: "memory");
    const int c = lane & 7;
#pragma unroll
    for (int j = 0; j < 4; ++j) { const int n = (lane >> 3) + 8 * j; const LAS float* s = scr + (8 * c) * 33 + n;
        v4u o; o.x = pk2(s[0 * 33], s[1 * 33]); o.y = pk2(s[2 * 33], s[3 * 33]); o.z = pk2(s[4 * 33], s[5 * 33]); o.w = pk2(s[6 * 33], s[7 * 33]);
        if (NTS) __builtin_nontemporal_store(o, (GAS v4u*)(WT + (size_t)(n0 + n) * ldk + koff + k0 + 8 * c)); else *(GAS v4u*)(WT + (size_t)(n0 + n) * ldk + koff + k0 + 8 * c) = o; }
    LDS_WAIT(); asm volatile("" ::: "memory");
}
__device__ __forceinline__ void p0_transpose_wq_item(const float* W, const float* g, const float* b, bf16* WT, float* c1, float* c2, LAS float* scr, int item, int lane) {
    constexpr int K = DM, N = DM;
    const int nblk = N / 32, kb = item / nblk, nb = item % nblk, k0 = 64 * kb, n0 = 32 * nb;
    float tv[32]; float p1 = 0.f, p2 = 0.f;
#pragma unroll
    for (int i = 0; i < 32; ++i) { const int kk = 2 * i + (lane >> 5); tv[i] = __builtin_nontemporal_load((const GAS float*)&W[(size_t)(k0 + kk) * N + n0 + (lane & 31)]); }
#pragma unroll
    for (int i = 0; i < 32; ++i) { const int kk = 2 * i + (lane >> 5); const float gw = tv[i] * g[k0 + kk];
        p1 += __uint_as_float(f2bf(gw) << 16); p2 = fmaf(tv[i], b[k0 + kk], p2); scr[kk * 33 + (lane & 31)] = gw; }
    p1 += __shfl_xor(p1, 32); p2 += __shfl_xor(p2, 32);
    if (lane < 32) { c1[(size_t)kb * N + n0 + lane] = p1; c2[(size_t)kb * N + n0 + lane] = p2; }
    LDS_WAIT(); asm volatile("" ::: "memory");
    const int c = lane & 7;
#pragma unroll
    for (int j = 0; j < 4; ++j) { const int n = (lane >> 3) + 8 * j; const LAS float* s = scr + (8 * c) * 33 + n;
        v4u o; o.x = pk2(s[0 * 33], s[1 * 33]); o.y = pk2(s[2 * 33], s[3 * 33]); o.z = pk2(s[4 * 33], s[5 * 33]); o.w = pk2(s[6 * 33], s[7 * 33]);
        *(GAS v4u*)(WT + (size_t)(n0 + n) * K + k0 + 8 * c) = o; }
    LDS_WAIT(); asm volatile("" ::: "memory");
}
__device__ __forceinline__ void convert_rows(const float* src, bf16* dst, size_t n8, size_t gtid, size_t nthr) {
    for (size_t i = gtid; i < n8; i += 4 * nthr) {
        f32x4 a[4], b[4];
#pragma unroll
        for (int u = 0; u < 4; ++u) { const size_t k = i + u * nthr; if (k < n8) { a[u] = __builtin_nontemporal_load((const GAS f32x4*)(src + k * 8)); b[u] = __builtin_nontemporal_load((const GAS f32x4*)(src + k * 8 + 4)); } }
#pragma unroll
        for (int u = 0; u < 4; ++u) { const size_t k = i + u * nthr; if (k < n8) { v4u o; o.x = pk2(a[u][0], a[u][1]); o.y = pk2(a[u][2], a[u][3]); o.z = pk2(b[u][0], b[u][1]); o.w = pk2(b[u][2], b[u][3]);
            *(GAS v4u*)(dst + k * 8) = o; } }
    }
}
constexpr int ROW6 = 1536;
typedef float f32x16 __attribute__((ext_vector_type(16)));
typedef unsigned u32x6 __attribute__((ext_vector_type(6)));
typedef unsigned u32x3 __attribute__((ext_vector_type(3)));
constexpr int FP6_CUS = 64;
__device__ __forceinline__ void convert_fp6_layer(Frame& F, int l, int cw, int nw) {
    unsigned char* P6 = F.ws + WS_PU8; float* SCL = (float*)(F.ws + WS_SCL);
    const int j = F.lane & 15, g = F.lane >> 4;
    for (int i0 = cw; i0 < 2 * NEXP; i0 += 4 * nw) {
        f32x4 v[4][8];
#pragma unroll
        for (int rr = 0; rr < 4; ++rr) { const int i = min(i0 + rr * nw, 2 * NEXP - 1); const int row = (i < NEXP) ? (l * NEXP + i) : ((2 + l) * NEXP + i - NEXP);
            const float* src = ((row >> 15) ? F.in[12] : F.in[11]) + (size_t)(row & (2 * NEXP - 1)) * DM;
#pragma unroll
            for (int ii = 0; ii < 8; ++ii) v[rr][ii] = __builtin_nontemporal_load((const GAS f32x4*)(src + (j + 16 * (8 * g + ii)) * 4)); }
        asm volatile("" : "+v"(v[0][0]), "+v"(v[0][1]), "+v"(v[0][2]), "+v"(v[0][3]), "+v"(v[0][4]), "+v"(v[0][5]), "+v"(v[0][6]), "+v"(v[0][7]),
                          "+v"(v[1][0]), "+v"(v[1][1]), "+v"(v[1][2]), "+v"(v[1][3]), "+v"(v[1][4]), "+v"(v[1][5]), "+v"(v[1][6]), "+v"(v[1][7]),
                          "+v"(v[2][0]), "+v"(v[2][1]), "+v"(v[2][2]), "+v"(v[2][3]), "+v"(v[2][4]), "+v"(v[2][5]), "+v"(v[2][6]), "+v"(v[2][7]));
        asm volatile("" : "+v"(v[3][0]), "+v"(v[3][1]), "+v"(v[3][2]), "+v"(v[3][3]), "+v"(v[3][4]), "+v"(v[3][5]), "+v"(v[3][6]), "+v"(v[3][7]));
#pragma unroll
        for (int rr = 0; rr < 4; ++rr) { const int i = i0 + rr * nw; if (i < 2 * NEXP) { const int row = (i < NEXP) ? (l * NEXP + i) : ((2 + l) * NEXP + i - NEXP);
            float m = 0.f;
#pragma unroll
            for (int ii = 0; ii < 8; ++ii) m = fmaxf(m, fmaxf(fmaxf(fabsf(v[rr][ii][0]), fabsf(v[rr][ii][1])), fmaxf(fabsf(v[rr][ii][2]), fabsf(v[rr][ii][3]))));
#pragma unroll
            for (int o = 1; o < 64; o <<= 1) m = fmaxf(m, __shfl_xor(m, o));
            const float sc = m > 0.f ? 7.5f / m : 1.0f, inv = m > 0.f ? m * (1.0f / 7.5f) : 1.0f;
            typedef _Float16 h32_t __attribute__((ext_vector_type(32)));
            h32_t hv;
#pragma unroll
            for (int ii = 0; ii < 8; ++ii)
#pragma unroll
                for (int c = 0; c < 4; ++c) hv[4 * ii + c] = (_Float16)(v[rr][ii][c] * sc);
            const u32x6 p = __builtin_amdgcn_cvt_scalef32_pk32_fp6_f16(hv, 1.0f);
            unsigned char* dst = P6 + (size_t)row * ROW6 + j * 16;
#pragma unroll
            for (int u = 0; u < 6; u += 2) { const int D = 6 * g + u;
                __builtin_nontemporal_store((unsigned long long)p[u] | ((unsigned long long)p[u + 1] << 32), (GAS unsigned long long*)(dst + 256 * (D >> 2) + 4 * (D & 3))); }
            if (F.lane == 0) SCL[row] = inv; } }
    }
}
constexpr int TI_IN = (DM / 64) * (IN_COLS / 32), TI_BR = (1024 / 64) * (DM / 32), TI_SQ = (DM / 64) * (DM / 32);
constexpr int TI_LAYER = TI_IN + 2 * TI_BR + 2 * TI_SQ, TI_ALL = DEPTH * TI_LAYER;
constexpr int TR_CU0 = 64, TR_CUS = 32, TW_CU0 = 96, TW_CUS = 64, SPREAD_MIN_G = 160;
__device__ __forceinline__ void transpose_range(Frame& F, int it_lo, int it_hi, int cw, int nw) {
    LAS float* scr = (LAS float*)(F.lds + RING_OFF + F.wave * 16384);
    for (int it = it_lo + cw; it < it_hi; it += nw) {
        const int l = it / TI_LAYER; int r = it % TI_LAYER;
        if (r < TI_IN) { if (l == 0) p0_transpose_item<false>(F.in[1], DM, IN_COLS, (bf16*)(F.ws + WS_WIN), DM, 0, scr, r, F.lane);
                         else p0_transpose_item<true>(F.in[1] + (size_t)l * DM * IN_COLS, DM, IN_COLS, (bf16*)(F.ws + WS_WIN) + (size_t)l * IN_COLS * DM, DM, 0, scr, r, F.lane); continue; } r -= TI_IN;
        if (r < TI_BR) { p0_transpose_item<false>(F.in[2] + (size_t)l * 1024 * DM, 1024, DM, (bf16*)(F.ws + WS_WBR) + (size_t)l * DM * DM, DM, 0, scr, r, F.lane); continue; } r -= TI_BR;
        if (r < TI_BR) { p0_transpose_item<false>(F.in[3] + (size_t)l * 1024 * DM, 1024, DM, (bf16*)(F.ws + WS_WBR) + (size_t)l * DM * DM, DM, 1024, scr, r, F.lane); continue; } r -= TI_BR;
        if (r < TI_SQ) { p0_transpose_item<false>(F.in[4] + (size_t)l * DM * DM, DM, DM, (bf16*)(F.ws + WS_WOUT) + (size_t)l * DM * DM, DM, 0, scr, r, F.lane); continue; } r -= TI_SQ;
        p0_transpose_wq_item(F.in[9] + (size_t)l * DM * DM, F.in[7] + (size_t)l * DM, F.in[8] + (size_t)l * DM, (bf16*)(F.ws + WS_WQ) + (size_t)l * DM * DM,
                             (float*)(F.ws + WS_C1P) + (size_t)l * 32 * DM, (float*)(F.ws + WS_C2P) + (size_t)l * 32 * DM, scr, r, F.lane);
    }
}
struct TrItem { const float* W; bf16* WT; int N, ldk, koff, r, kind, l; };
__device__ __forceinline__ TrItem tr_decode(Frame& F, int it) {
    TrItem t; t.l = it / TI_LAYER; int r = it % TI_LAYER; const int l = t.l; t.kind = 0;
    if (r < TI_IN) { t.W = F.in[1] + (size_t)l * DM * IN_COLS; t.WT = (bf16*)(F.ws + WS_WIN) + (size_t)l * IN_COLS * DM; t.N = IN_COLS; t.ldk = DM; t.koff = 0; t.r = r; return t; } r -= TI_IN;
    if (r < TI_BR) { t.W = F.in[2] + (size_t)l * 1024 * DM; t.WT = (bf16*)(F.ws + WS_WBR) + (size_t)l * DM * DM; t.N = DM; t.ldk = DM; t.koff = 0; t.r = r; return t; } r -= TI_BR;
    if (r < TI_BR) { t.W = F.in[3] + (size_t)l * 1024 * DM; t.WT = (bf16*)(F.ws + WS_WBR) + (size_t)l * DM * DM; t.N = DM; t.ldk = DM; t.koff = 1024; t.r = r; return t; } r -= TI_BR;
    if (r < TI_SQ) { t.W = F.in[4] + (size_t)l * DM * DM; t.WT = (bf16*)(F.ws + WS_WOUT) + (size_t)l * DM * DM; t.N = DM; t.ldk = DM; t.koff = 0; t.r = r; return t; } r -= TI_SQ;
    t.kind = 1; t.W = F.in[9] + (size_t)l * DM * DM; t.WT = (bf16*)(F.ws + WS_WQ) + (size_t)l * DM * DM; t.N = DM; t.ldk = DM; t.koff = 0; t.r = r; return t;
}
__device__ __forceinline__ void tr_load(const TrItem& t, int lane, f32x4 (&v)[8]) {
    const int nblk = t.N / 32, kb = t.r / nblk, nb = t.r % nblk, k0 = 64 * kb, n0 = 32 * nb;
#pragma unroll
    for (int i = 0; i < 32; ++i) { const int kk = 2 * i + (lane >> 5); v[i >> 2][i & 3] = __builtin_nontemporal_load((const GAS float*)&t.W[(size_t)(k0 + kk) * t.N + n0 + (lane & 31)]); }
}
__device__ __forceinline__ void tr_store(const TrItem& t, const f32x4 (&v)[8], LAS float* scr, int lane) {
    const int nblk = t.N / 32, kb = t.r / nblk, nb = t.r % nblk, k0 = 64 * kb, n0 = 32 * nb;
#pragma unroll
    for (int i = 0; i < 32; ++i) { const int kk = 2 * i + (lane >> 5); scr[kk * 33 + (lane & 31)] = v[i >> 2][i & 3]; }
    LDS_WAIT(); asm volatile("" ::: "memory");
    const int c = lane & 7;
#pragma unroll
    for (int j = 0; j < 4; ++j) { const int n = (lane >> 3) + 8 * j; const LAS float* sp = scr + (8 * c) * 33 + n;
        v4u o; o.x = pk2(sp[0 * 33], sp[1 * 33]); o.y = pk2(sp[2 * 33], sp[3 * 33]); o.z = pk2(sp[4 * 33], sp[5 * 33]); o.w = pk2(sp[6 * 33], sp[7 * 33]);
        *(GAS v4u*)(t.WT + (size_t)(n0 + n) * t.ldk + t.koff + k0 + 8 * c) = o; }
    LDS_WAIT(); asm volatile("" ::: "memory");
}
__device__ __forceinline__ void transpose_range_deep(Frame& F, int it_lo, int it_hi, int cw, int nw) {
    LAS float* scr = (LAS float*)(F.lds + RING_OFF + F.wave * 16384);
    for (int it0 = it_lo + cw; it0 < it_hi; it0 += 4 * nw) {
        TrItem t[4]; f32x4 v[4][8];
#pragma unroll
        for (int u = 0; u < 4; ++u) { const int it = it0 + u * nw; t[u] = tr_decode(F, it < it_hi ? it : it0);
#pragma unroll
            for (int i = 0; i < 8; ++i) v[u][i] = (f32x4){0.f, 0.f, 0.f, 0.f};
            if (it < it_hi && t[u].kind == 0) tr_load(t[u], F.lane, v[u]); }
        asm volatile("" : "+v"(v[0][0]), "+v"(v[0][1]), "+v"(v[0][2]), "+v"(v[0][3]), "+v"(v[0][4]), "+v"(v[0][5]), "+v"(v[0][6]), "+v"(v[0][7]),
                          "+v"(v[1][0]), "+v"(v[1][1]), "+v"(v[1][2]), "+v"(v[1][3]), "+v"(v[1][4]), "+v"(v[1][5]), "+v"(v[1][6]), "+v"(v[1][7]));
        asm volatile("" : "+v"(v[2][0]), "+v"(v[2][1]), "+v"(v[2][2]), "+v"(v[2][3]), "+v"(v[2][4]), "+v"(v[2][5]), "+v"(v[2][6]), "+v"(v[2][7]),
                          "+v"(v[3][0]), "+v"(v[3][1]), "+v"(v[3][2]), "+v"(v[3][3]), "+v"(v[3][4]), "+v"(v[3][5]), "+v"(v[3][6]), "+v"(v[3][7]));
#pragma unroll
        for (int u = 0; u < 4; ++u) { const int it = it0 + u * nw; if (it < it_hi) {
            if (t[u].kind == 1) { const int l = t[u].l;
                p0_transpose_wq_item(F.in[9] + (size_t)l * DM * DM, F.in[7] + (size_t)l * DM, F.in[8] + (size_t)l * DM, (bf16*)(F.ws + WS_WQ) + (size_t)l * DM * DM,
                                     (float*)(F.ws + WS_C1P) + (size_t)l * 32 * DM, (float*)(F.ws + WS_C2P) + (size_t)l * 32 * DM, scr, t[u].r, F.lane); }
            else tr_store(t[u], v[u], scr, F.lane); } }
    }
}
__device__ __forceinline__ void p0_prologue(Frame& F) {
    const int gw = F.vcu * NWAVES + F.wave, NGW = F.G * NWAVES;
    const size_t gtid = (size_t)F.vcu * (NWAVES * 64) + F.tid, nthr = (size_t)F.G * NWAVES * 64;
    if (F.vcu & 1) convert_rows(F.in[0], (bf16*)(F.ws + WS_XB), (size_t)T * DM / 8, gtid, nthr);
    transpose_range(F, 0, F.G >= SPREAD_MIN_G ? TI_IN : TI_ALL, gw, NGW);
    convert_rows(F.in[10], (bf16*)(F.ws + WS_SUBK), (size_t)DEPTH * 8 * 2 * 128 * 128 / 8, gtid, nthr);
    if (!(F.vcu & 1)) convert_rows(F.in[0], (bf16*)(F.ws + WS_XB), (size_t)T * DM / 8, gtid, nthr);
    float* cosT = (float*)(F.ws + WS_ROPE); float* sinT = cosT + SEQ * 16;
    for (size_t i = gtid; i < (size_t)SEQ * 16; i += nthr) {
        const int pos = (int)(i >> 4), k = (int)(i & 15);
        const float inv = 1.0f / powf(500000.0f, (float)k * (1.0f / 16.0f));
        const float ang = (float)pos * inv;
        cosT[i] = (float)cos((double)ang); sinT[i] = (float)sin((double)ang);
    }
}

__device__ __forceinline__ void kmean_phase(Frame& F) {
    const bf16* KM = (const bf16*)(F.ws + WS_QKV) + (size_t)1 * T * 1024;
    float* KMEAN = (float*)(F.ws + WS_KMEAN);
    LAS float* red = (LAS float*)(F.lds + RING_OFF);
    const int cg = F.tid & 15, rg = F.tid >> 4;
    for (int it = F.vcu; it < 256; it += F.G) {
        const bf16* base = KM + ((size_t)(it >> 4) * SEQ + (size_t)(it & 15) * 256) * 128;
        float s[8] = {0, 0, 0, 0, 0, 0, 0, 0};
#pragma unroll
        for (int i = 0; i < 8; ++i) { const v4u w = *(const GAS v4u*)(base + (size_t)(rg * 8 + i) * 128 + cg * 8);
            s[0] += bflo(w.x); s[1] += bfhi(w.x); s[2] += bflo(w.y); s[3] += bfhi(w.y); s[4] += bflo(w.z); s[5] += bfhi(w.z); s[6] += bflo(w.w); s[7] += bfhi(w.w); }
#pragma unroll
        for (int j = 0; j < 8; ++j) red[rg * 128 + cg * 8 + j] = s[j];
        __syncthreads();
        if (F.tid < 128) { float a = 0.f;
#pragma unroll 8
            for (int g = 0; g < 32; ++g) a += red[g * 128 + F.tid];
            KMEAN[(size_t)it * 128 + F.tid] = a * (1.0f / 256.0f); }
        __syncthreads();
    }
}

__device__ __forceinline__ int att_fetch(Frame& F, gu32* head) {
    if (F.tid == 0) F.MISC[0] = __hip_atomic_fetch_add(head, 1u, __ATOMIC_RELAXED, __HIP_MEMORY_SCOPE_AGENT);
    __syncthreads();
    const int v = (int)F.MISC[0];
    __syncthreads();
    return v;
}
__device__ __forceinline__ att::BlockRef<bf16, bf16> att_ref(unsigned char* ws, int L) {
    att::BlockRef<bf16, bf16> r;
    const int qb = 15 - L / 48, rem = L % 48;
    const bf16* QKV = (const bf16*)(ws + WS_QKV); const size_t REG = (size_t)T * 1024;
    r.P0 = qb * 256;
    if (rem >= 16) {
        const int x = rem - 16, b = x >> 4, h = (x >> 2) & 3, comp = (x >> 1) & 1, half = x & 1;
        const size_t qk = ((size_t)(b * 8 + h * 2 + comp) * SEQ) * 128, vv = ((size_t)(b * 8 + h * 2 + half) * SEQ) * 128;
        r.Q = QKV + 3 * REG + qk + (size_t)qb * 256 * 128; r.K = QKV + 4 * REG + qk; r.V = QKV + 5 * REG + vv;
        r.O = (bf16*)(ws + WS_OD) + ((size_t)(((b * 4 + h) * 2 + comp) * 2 + half) * SEQ + (size_t)qb * 256) * 128;
        r.ostride = 128; r.moba = 0; r.kmean = (const float*)(ws + WS_KMEAN);
    } else {
        const int b = rem >> 3, h = rem & 7;
        const size_t hh = ((size_t)(b * 8 + h) * SEQ) * 128;
        r.Q = QKV + hh + (size_t)qb * 256 * 128; r.K = QKV + 1 * REG + hh; r.V = QKV + 2 * REG + hh;
        r.O = (bf16*)(ws + WS_YMD) + ((size_t)b * SEQ + (size_t)qb * 256) * 2048 + h * 128;
        r.ostride = 2048; r.moba = 1; r.kmean = (const float*)(ws + WS_KMEAN) + (size_t)(b * 8 + h) * 16 * 128;
    }
    return r;
}

__device__ __forceinline__ void diffcomb_phase(Frame& F, int l) {
    const float* lamf = F.in[5] + (size_t)l * 4 * 128; const float* sg = F.in[6] + (size_t)l * 256;
    const float lambda_init = 0.8f - 0.6f * expf(-0.3f * (float)l);
    const float d1 = wave_sum(lamf[F.lane] * lamf[128 + F.lane] + lamf[64 + F.lane] * lamf[128 + 64 + F.lane]);
    const float d2 = wave_sum(lamf[256 + F.lane] * lamf[384 + F.lane] + lamf[256 + 64 + F.lane] * lamf[384 + 64 + F.lane]);
    const float lam = expf(d1) - expf(d2) + lambda_init;
    const bf16* OD = (const bf16*)(F.ws + WS_OD); bf16* YD = (bf16*)(F.ws + WS_YMD) + 1024;
    const int gw = F.vcu * NWAVES + F.wave, NGW = F.G * NWAVES;
    const int q = F.lane >> 4, j = F.lane & 15, half = j >> 3, c = (j & 7) * 16;
    f32x4 g4[4];
#pragma unroll
    for (int k = 0; k < 4; ++k) g4[k] = *(const GAS f32x4*)(sg + half * 128 + c + 4 * k);
    for (int base = gw * 4; base < T * 4; base += 16 * NGW) {
        v4u wa[4][2], wb[4][2];
#pragma unroll
        for (int p = 0; p < 4; ++p) { const int it = min(base + p * 4 * NGW + q, T * 4 - 1);
            const int t = it >> 2, h = it & 3, b = t >> 12, sq = t & 4095;
            const size_t o0 = ((size_t)(((b * 4 + h) * 2 + 0) * 2 + half) * SEQ + sq) * 128 + c, o1 = ((size_t)(((b * 4 + h) * 2 + 1) * 2 + half) * SEQ + sq) * 128 + c;
            wa[p][0] = *(const GAS v4u*)(OD + o0); wa[p][1] = *(const GAS v4u*)(OD + o0 + 8); wb[p][0] = *(const GAS v4u*)(OD + o1); wb[p][1] = *(const GAS v4u*)(OD + o1 + 8); }
        asm volatile("" : "+v"(wa[0][0]), "+v"(wa[0][1]), "+v"(wa[1][0]), "+v"(wa[1][1]), "+v"(wa[2][0]), "+v"(wa[2][1]), "+v"(wa[3][0]), "+v"(wa[3][1]),
                          "+v"(wb[0][0]), "+v"(wb[0][1]), "+v"(wb[1][0]), "+v"(wb[1][1]), "+v"(wb[2][0]), "+v"(wb[2][1]), "+v"(wb[3][0]), "+v"(wb[3][1]));
#pragma unroll
        for (int p = 0; p < 4; ++p) { const int it = base + p * 4 * NGW + q; if (it < T * 4) {
            const int t = it >> 2, h = it & 3;
            float o[16]; float ss = 0.f;
#pragma unroll
            for (int k = 0; k < 8; ++k) { const unsigned ua = wa[p][k >> 2][k & 3], ub = wb[p][k >> 2][k & 3];
                o[2 * k] = bflo(ua) - bflo(ub) * lam; o[2 * k + 1] = bfhi(ua) - bfhi(ub) * lam; ss += o[2 * k] * o[2 * k] + o[2 * k + 1] * o[2 * k + 1]; }
            { float v = ss;
              v += __builtin_bit_cast(float, __builtin_amdgcn_update_dpp(0, __builtin_bit_cast(int, v), 0x128, 0xf, 0xf, false));
              v += __builtin_bit_cast(float, __builtin_amdgcn_update_dpp(0, __builtin_bit_cast(int, v), 0x124, 0xf, 0xf, false));
              v += __builtin_bit_cast(float, __builtin_amdgcn_update_dpp(0, __builtin_bit_cast(int, v), 0x122, 0xf, 0xf, false));
              v += __builtin_bit_cast(float, __builtin_amdgcn_update_dpp(0, __builtin_bit_cast(int, v), 0x121, 0xf, 0xf, false)); ss = v; }
            const float rs = 1.0f / sqrtf(ss * (1.0f / 256.0f) + RMS_EPS) * (1.0f - lambda_init);
            v4u y0, y1;
#pragma unroll
            for (int k = 0; k < 4; ++k) { y0[k] = pk2(o[2 * k] * rs * g4[k >> 1][(2 * k) & 3], o[2 * k + 1] * rs * g4[k >> 1][(2 * k + 1) & 3]);
                                          y1[k] = pk2(o[8 + 2 * k] * rs * g4[2 + (k >> 1)][(2 * k) & 3], o[8 + 2 * k + 1] * rs * g4[2 + (k >> 1)][(2 * k + 1) & 3]); }
            bf16* yp = YD + (size_t)t * 2048 + h * 256 + half * 128 + c;
            *(GAS v4u*)yp = y0; *(GAS v4u*)(yp + 8) = y1; } }
    }
}

__device__ __forceinline__ void ln1_phase(Frame& F, int l) {
    const float* Y = (const float*)(F.ws + WS_MF); bf16* X1B = (bf16*)(F.ws + WS_X1B);
    const float* g = F.in[7] + (size_t)l * DM; const float* bta = F.in[8] + (size_t)l * DM;
    const int gw = F.vcu * NWAVES + F.wave, NGW = F.G * NWAVES;
    for (int m = gw; m < T; m += NGW) {
        const GAS f32x4* xr = (const GAS f32x4*)(Y + (size_t)m * DM) + F.lane;
        f32x4 v[8]; float s = 0.f;
#pragma unroll
        for (int j = 0; j < 8; ++j) { v[j] = xr[64 * j]; s += (v[j].x + v[j].y) + (v[j].z + v[j].w); }
        const float mean = wave_sum(s) * (1.f / DM); float s2 = 0.f;
#pragma unroll
        for (int j = 0; j < 8; ++j) { v[j] = v[j] - mean; s2 += (v[j].x * v[j].x + v[j].y * v[j].y) + (v[j].z * v[j].z + v[j].w * v[j].w); }
        const float rstd = 1.f / sqrtf(wave_sum(s2) * (1.f / DM) + LN_EPS);
        GAS unsigned long long* o8 = (GAS unsigned long long*)(X1B + (size_t)m * DM) + F.lane;
#pragma unroll
        for (int j = 0; j < 8; ++j) { const f32x4 gg = ((const GAS f32x4*)g)[F.lane + 64 * j], bb = ((const GAS f32x4*)bta)[F.lane + 64 * j];
            const f32x4 y = v[j] * rstd * gg + bb;
            o8[64 * j] = (unsigned long long)pk2(y.x, y.y) | ((unsigned long long)pk2(y.z, y.w) << 32); }
    }
}

__device__ __forceinline__ unsigned mkkey(float f, unsigned low, unsigned mask) {
    unsigned u = __float_as_uint(f); u = (u & 0x80000000u) ? ~u : (u | 0x80000000u); return (u & ~mask) | low; }
__device__ __forceinline__ float keyval(unsigned k, unsigned mask) {
    const unsigned u = k & ~mask; return __uint_as_float((u & 0x80000000u) ? (u & 0x7fffffffu) : ~u); }
#define INS16(L, key_) do { unsigned k_ = (key_); _Pragma("unroll") for (int i_ = 0; i_ < 16; ++i_) { const unsigned h_ = max(L[i_], k_); k_ = min(L[i_], k_); L[i_] = h_; } } while (0)
__device__ __forceinline__ void bitonic_desc16(unsigned (&C)[16]) {
#pragma unroll
    for (int d = 8; d >= 1; d >>= 1)
#pragma unroll
        for (int i = 0; i < 16; ++i) if ((i & d) == 0) { const unsigned a = max(C[i], C[i + d]), b = min(C[i], C[i + d]); C[i] = a; C[i + d] = b; }
}
__device__ __forceinline__ void bitonic_sort16_desc(unsigned (&C)[16]) {
#define CE_(i, j) do { const unsigned hi_ = max(C[i], C[j]), lo_ = min(C[i], C[j]); C[i] = hi_; C[j] = lo_; } while (0)
    CE_(0,1); CE_(2,3); CE_(0,2); CE_(1,3); CE_(1,2); CE_(4,5); CE_(6,7); CE_(4,6); CE_(5,7); CE_(5,6); CE_(0,4); CE_(2,6); CE_(2,4); CE_(1,5); CE_(3,7); CE_(3,5); CE_(1,2); CE_(3,4); CE_(5,6); CE_(8,9); CE_(10,11); CE_(8,10); CE_(9,11); CE_(9,10); CE_(12,13); CE_(14,15); CE_(12,14); CE_(13,15); CE_(13,14); CE_(8,12); CE_(10,14); CE_(10,12); CE_(9,13); CE_(11,15); CE_(11,13); CE_(9,10); CE_(11,12); CE_(13,14); CE_(0,8); CE_(4,12); CE_(4,8); CE_(2,10); CE_(6,14); CE_(6,10); CE_(2,4); CE_(6,8); CE_(10,12); CE_(1,9); CE_(5,13); CE_(5,9); CE_(3,11); CE_(7,15); CE_(7,11); CE_(3,5); CE_(7,9); CE_(11,13); CE_(1,2); CE_(3,4); CE_(5,6); CE_(7,8); CE_(9,10); CE_(11,12); CE_(13,14);
#undef CE_
}
__device__ __forceinline__ void merge_top16(unsigned (&L)[16], const unsigned (&C)[16]) {
#pragma unroll
    for (int i = 0; i < 16; ++i) L[i] = max(L[i], C[15 - i]);
    bitonic_desc16(L);
}
__device__ __forceinline__ void peer_topk_phase(Frame& F, int l) {
    typedef float f32x16 __attribute__((ext_vector_type(16)));
    const bf16* QP = (const bf16*)(F.ws + WS_QP); const bf16* SK = (const bf16*)(F.ws + WS_SUBK) + (size_t)l * 8 * 2 * 128 * 128;
    int* IDX = (int*)(F.ws + WS_IDX); float* GATE = (float*)(F.ws + WS_GATE);
    const int gw = F.vcu * NWAVES + F.wave, NGW = F.G * NWAVES;
    const int r32 = F.lane & 31, hi = F.lane >> 5;
    for (int it = gw; it < 2048; it += NGW) {
        const int h = it >> 8, g = it & 255, t = g * 32 + r32;
        unsigned LA[16], LB[16];
#pragma unroll
        for (int c = 0; c < 2; ++c) {
            bf16x8 qf[8];
#pragma unroll
            for (int d0 = 0; d0 < 8; ++d0) qf[d0] = *(const GAS bf16x8*)(QP + (size_t)t * DM + h * 256 + c * 128 + d0 * 16 + hi * 8);
            unsigned L[16];
#pragma unroll
            for (int i = 0; i < 16; ++i) L[i] = 0u;
#pragma unroll
            for (int nt = 0; nt < 4; ++nt) {
                f32x16 p = {0, 0, 0, 0, 0, 0, 0, 0, 0, 0, 0, 0, 0, 0, 0, 0};
                const bf16* kr = SK + ((size_t)(h * 2 + c) * 128 + nt * 32 + r32) * 128 + hi * 8;
#pragma unroll
                for (int d0 = 0; d0 < 8; ++d0) { const bf16x8 kf = *(const GAS bf16x8*)(kr + d0 * 16);
                    p = __builtin_amdgcn_mfma_f32_32x32x16_bf16(kf, qf[d0], p, 0, 0, 0); }
                unsigned Kx[16];
#pragma unroll
                for (int r = 0; r < 16; ++r) { const int n = nt * 32 + (r & 3) + 8 * (r >> 2) + 4 * hi;
                    Kx[r] = mkkey(p[r], (unsigned)(127 - n), 127u); }
                bitonic_sort16_desc(Kx);
                if (nt == 0) {
#pragma unroll
                    for (int i = 0; i < 16; ++i) L[i] = Kx[i];
                } else merge_top16(L, Kx);
            }
            unsigned C[16];
#pragma unroll
            for (int i = 0; i < 16; ++i) { const unsigned o = (unsigned)__shfl_xor((int)L[15 - i], 32); C[i] = max(L[i], o); }
            bitonic_desc16(C);
#pragma unroll
            for (int i = 0; i < 16; ++i) { if (c == 0) LA[i] = C[i]; else LB[i] = C[i]; }
        }
        float a[16], b[16];
#pragma unroll
        for (int i = 0; i < 16; ++i) { a[i] = keyval(LA[i], 127u); b[i] = keyval(LB[i], 127u); }
#define CK(i, j) mkkey(a[i] + b[j], (unsigned)(255 - ((i) * 16 + (j))), 255u)
        unsigned M[16], G[16];
#pragma unroll
        for (int j = 0; j < 16; ++j) M[j] = CK(0, j);
#pragma unroll
        for (int j = 0; j < 8; ++j) { G[j] = CK(1, j); G[15 - j] = CK(8 + j, 0); }
        bitonic_desc16(G); merge_top16(M, G);
        G[0] = CK(2, 0); G[1] = CK(2, 1); G[2] = CK(2, 2); G[3] = CK(2, 3); G[4] = CK(2, 4); G[5] = CK(3, 0); G[6] = CK(3, 1); G[7] = CK(3, 2); G[8] = CK(3, 3);
        G[9] = CK(4, 0); G[10] = CK(4, 1); G[11] = CK(4, 2); G[12] = CK(5, 0); G[13] = CK(5, 1); G[14] = 0u; G[15] = 0u;
        bitonic_sort16_desc(G); merge_top16(M, G);
        INS16(M, CK(6, 0)); INS16(M, CK(6, 1)); INS16(M, CK(7, 0)); INS16(M, CK(7, 1));
#undef CK
        float e[16]; float se = 0.f; const float m0 = keyval(M[0], 255u);
#pragma unroll
        for (int k = 0; k < 16; ++k) { e[k] = __expf(keyval(M[k], 255u) - m0); se += e[k]; }
        const float inv = 1.0f / se;
        unsigned IA[4], IB[4];
#pragma unroll
        for (int w = 0; w < 4; ++w) { IA[w] = (LA[4 * w] & 127u) | ((LA[4 * w + 1] & 127u) << 8) | ((LA[4 * w + 2] & 127u) << 16) | ((LA[4 * w + 3] & 127u) << 24);
                                      IB[w] = (LB[4 * w] & 127u) | ((LB[4 * w + 1] & 127u) << 8) | ((LB[4 * w + 2] & 127u) << 16) | ((LB[4 * w + 3] & 127u) << 24); }
        int ex[8]; float gt[8];
#pragma unroll
        for (int kk = 0; kk < 8; ++kk) {
            const unsigned mk = hi ? M[8 + kk] : M[kk]; gt[kk] = (hi ? e[8 + kk] : e[kk]) * inv;
            const int code = 255 - (int)(mk & 255u), ci = code >> 4, cj = code & 15;
            const unsigned wa_ = (ci >> 2) == 0 ? IA[0] : ((ci >> 2) == 1 ? IA[1] : ((ci >> 2) == 2 ? IA[2] : IA[3]));
            const unsigned wb_ = (cj >> 2) == 0 ? IB[0] : ((cj >> 2) == 1 ? IB[1] : ((cj >> 2) == 2 ? IB[2] : IB[3]));
            const unsigned ka = (wa_ >> ((ci & 3) * 8)) & 127u, kb = (wb_ >> ((cj & 3) * 8)) & 127u;
            ex[kk] = (127 - (int)ka) * 128 + (127 - (int)kb);
        }
        int* ip = IDX + (size_t)t * 128 + h * 16 + hi * 8; float* gp = GATE + (size_t)t * 128 + h * 16 + hi * 8;
        *(GAS v4u*)ip = (v4u){(unsigned)ex[0], (unsigned)ex[1], (unsigned)ex[2], (unsigned)ex[3]};
        *(GAS v4u*)(ip + 4) = (v4u){(unsigned)ex[4], (unsigned)ex[5], (unsigned)ex[6], (unsigned)ex[7]};
        *(GAS f32x4*)gp = (f32x4){gt[0], gt[1], gt[2], gt[3]};
        *(GAS f32x4*)(gp + 4) = (f32x4){gt[4], gt[5], gt[6], gt[7]};
    }
}

typedef float f32x2 __attribute__((ext_vector_type(2)));
typedef unsigned u32x8 __attribute__((ext_vector_type(8)));
typedef _Float16 h2 __attribute__((ext_vector_type(2)));
typedef _Float16 h32 __attribute__((ext_vector_type(32)));
typedef __attribute__((__vector_size__(2 * sizeof(__fp16)))) __fp16 fp16x2_t;
__device__ __forceinline__ float gelu_exact(float x) { return 0.5f * x * (1.0f + erff(x * 0.70710678118654752f)); }
__device__ __forceinline__ float dpp_row_shr(float v, int n) {
    const int iv = __builtin_bit_cast(int, v); int r;
    switch (n) { case 1: r = __builtin_amdgcn_update_dpp(0, iv, 0x111, 0xf, 0xf, true); break; case 2: r = __builtin_amdgcn_update_dpp(0, iv, 0x112, 0xf, 0xf, true); break;
                 case 4: r = __builtin_amdgcn_update_dpp(0, iv, 0x114, 0xf, 0xf, true); break; default: r = __builtin_amdgcn_update_dpp(0, iv, 0x118, 0xf, 0xf, true); break; }
    return __builtin_bit_cast(float, r);
}
__device__ __forceinline__ float group_sum16(float v) { v += __shfl_xor(v, 1); v += __shfl_xor(v, 2); v += __shfl_xor(v, 4); v += __shfl_xor(v, 8); return v; }
__device__ __forceinline__ void sort128g(u32x8& K, int j) {
#pragma unroll
    for (int size = 2; size <= 128; size <<= 1)
#pragma unroll
        for (int stride = size >> 1; stride >= 1; stride >>= 1) {
            if (stride >= 16) { const int rs = stride >> 4;
#pragma unroll
                for (int r = 0; r < 8; ++r) if ((r & rs) == 0) { const bool up = (((r * 16) & size) == 0);
                    const unsigned a = K[r], b = K[r | rs], lo = min(a, b), hi = max(a, b); K[r] = up ? lo : hi; K[r | rs] = up ? hi : lo; }
            } else {
#pragma unroll
                for (int r = 0; r < 8; ++r) { const unsigned o = (unsigned)__shfl_xor((int)K[r], stride);
                    const bool up = (((r * 16 + j) & size) == 0), lower = ((j & stride) == 0);
                    K[r] = (up == lower) ? min(K[r], o) : max(K[r], o); }
            }
        }
}
struct RowBuf { v4u d[6]; };
template <int MODE>
__device__ __forceinline__ unsigned row_issue(RowBuf& b, const unsigned char* table, const volatile LAS unsigned* KLq, const volatile LAS _Float16* TCq, int p, int j) {
    const unsigned key = KLq[p < 127 ? p : 127];
    const unsigned char* src = table + (size_t)(((key >> 7) & 16383u) * (unsigned)ROW6 + (unsigned)j * 16u);
#pragma unroll
    for (int n = 0; n < 6; ++n) b.d[n] = *(const GAS v4u*)(src + 256 * n);
    if (MODE == 0) return key & 127u;
    const _Float16 c_ = TCq[key & 127u]; return (unsigned)__builtin_bit_cast(unsigned short, c_);
}
template <int MODE>
__device__ __forceinline__ void row_consume(const RowBuf& b, const unsigned e, volatile LAS _Float16* TCq, int j, h2 (&xa)[64]) {
    if (MODE == 0) {
        float s0 = 0.f, s1 = 0.f;
#pragma unroll
        for (int g = 0; g < 4; ++g) { const u32x6 w = {b.d[(6 * g) >> 2][(6 * g) & 3], b.d[(6 * g + 1) >> 2][(6 * g + 1) & 3], b.d[(6 * g + 2) >> 2][(6 * g + 2) & 3], b.d[(6 * g + 3) >> 2][(6 * g + 3) & 3], b.d[(6 * g + 4) >> 2][(6 * g + 4) & 3], b.d[(6 * g + 5) >> 2][(6 * g + 5) & 3]};
            const h32 r = __builtin_amdgcn_cvt_scalef32_pk32_f16_fp6(w, 1.0f);
#pragma unroll
            for (int m = 0; m < 16; m += 2) {
                s0 = __builtin_amdgcn_fdot2(__builtin_bit_cast(fp16x2_t, (h2){r[2 * m], r[2 * m + 1]}), __builtin_bit_cast(fp16x2_t, xa[16 * g + m]), s0, false);
                s1 = __builtin_amdgcn_fdot2(__builtin_bit_cast(fp16x2_t, (h2){r[2 * m + 2], r[2 * m + 3]}), __builtin_bit_cast(fp16x2_t, xa[16 * g + m + 1]), s1, false); } }
        float s = s0 + s1;
        s += dpp_row_shr(s, 1); s += dpp_row_shr(s, 2); s += dpp_row_shr(s, 4); s += dpp_row_shr(s, 8);
        if (j == 15) TCq[e] = (_Float16)s;
    } else {
        const _Float16 cq = __builtin_bit_cast(_Float16, (unsigned short)e); const h2 c2 = {cq, cq};
#pragma unroll
        for (int g = 0; g < 4; ++g) { const u32x6 w = {b.d[(6 * g) >> 2][(6 * g) & 3], b.d[(6 * g + 1) >> 2][(6 * g + 1) & 3], b.d[(6 * g + 2) >> 2][(6 * g + 2) & 3], b.d[(6 * g + 3) >> 2][(6 * g + 3) & 3], b.d[(6 * g + 4) >> 2][(6 * g + 4) & 3], b.d[(6 * g + 5) >> 2][(6 * g + 5) & 3]};
            const h32 r = __builtin_amdgcn_cvt_scalef32_pk32_f16_fp6(w, 1.0f);
#pragma unroll
            for (int m = 0; m < 16; ++m) xa[16 * g + m] = __builtin_elementwise_fma((h2){r[2 * m], r[2 * m + 1]}, c2, xa[16 * g + m]); }
    }
}
template <int MODE>
__device__ __forceinline__ void sweep4(const unsigned char* table, h2 (&xa)[64], const volatile LAS unsigned* KLq, volatile LAS _Float16* TCq, const int j) {
    RowBuf b0, b1, b2, b3;
    unsigned e0 = row_issue<MODE>(b0, table, KLq, TCq, 0, j), e1 = row_issue<MODE>(b1, table, KLq, TCq, 1, j), e2 = row_issue<MODE>(b2, table, KLq, TCq, 2, j), e3 = row_issue<MODE>(b3, table, KLq, TCq, 3, j);
    for (int p = 0; p < 128; p += 4) {
        row_consume<MODE>(b0, e0, TCq, j, xa); e0 = row_issue<MODE>(b0, table, KLq, TCq, p + 4, j);
        row_consume<MODE>(b1, e1, TCq, j, xa); e1 = row_issue<MODE>(b1, table, KLq, TCq, p + 5, j);
        row_consume<MODE>(b2, e2, TCq, j, xa); e2 = row_issue<MODE>(b2, table, KLq, TCq, p + 6, j);
        row_consume<MODE>(b3, e3, TCq, j, xa); e3 = row_issue<MODE>(b3, table, KLq, TCq, p + 7, j);
    }
    asm volatile("s_waitcnt vmcnt(0)" ::: "memory");
    asm volatile("s_waitcnt lgkmcnt(0)" ::: "memory");
}
__device__ __forceinline__ void peer_expert_phase(Frame& F, int l, const bool last) {
#define PWS ((unsigned char*)ctx_ld(16))
#define PU ((const unsigned char*)(PWS + WS_PU8 + (size_t)l * NEXP * ROW6))
#define PV ((const unsigned char*)(PWS + WS_PV8 + (size_t)l * NEXP * ROW6))
#define SU ((const float*)(PWS + WS_SCL) + (size_t)l * NEXP)
#define SV ((const float*)(PWS + WS_SCL) + (size_t)(2 + l) * NEXP)
#define X1B_ ((const bf16*)(PWS + WS_X1B))
#define RSP_ ((const float*)(PWS + WS_RSP) + (size_t)l * T * 64)
#define IDX ((const int*)(PWS + WS_IDX))
#define GATE ((const float*)(PWS + WS_GATE))
    const int gw = F.vcu * NWAVES + F.wave, NGW = F.G * NWAVES;
    volatile LAS unsigned* KL = (volatile LAS unsigned*)(F.lds + RING_OFF + F.wave * 2048);
    volatile LAS _Float16* TC = (volatile LAS _Float16*)(F.lds + PEER_TC16_OFF + F.wave * 1024);
    for (int tg = gw; tg < T / 4; tg += NGW) {
        const int lane_ = opq_tid(0), q = lane_ >> 4, j = lane_ & 15;
        const int t = tg * 4 + q;
        u32x8 K;
        { const int* idx_ = IDX;
#pragma unroll
          for (int r = 0; r < 8; ++r) { const int e = r * 16 + j; K[r] = (((unsigned)idx_[(size_t)t * 128 + e] & 16383u) << 7) | (unsigned)e; } }
        sort128g(K, j);
#pragma unroll
        for (int r = 0; r < 8; ++r) KL[q * 128 + r * 16 + j] = K[r];
        float mu1, rstd1;
        { const float* rs_ = RSP_ + (size_t)t * 64;
          const float s1_ = group_sum16(rs_[2 * j] + rs_[2 * (j + 16)]), s2_ = group_sum16(rs_[2 * j + 1] + rs_[2 * (j + 16) + 1]);
          mu1 = s1_ * (1.f / DM); rstd1 = 1.f / sqrtf(s2_ * (1.f / DM) - mu1 * mu1 + LN_EPS); }
        {
            h2 xr[64];
            { int jx = j; asm volatile("" : "+v"(jx));
              const bf16* x1_ = X1B_ + (size_t)t * DM; const float* g1_ = (const float*)ctx_ld(7) + (size_t)l * DM; const float* b1_ = (const float*)ctx_ld(8) + (size_t)l * DM;
#pragma unroll
              for (int i0 = 0; i0 < 32; i0 += 8) {
                  unsigned long long w[8]; f32x4 gg[8], bb[8];
#pragma unroll
                  for (int u = 0; u < 8; ++u) { const int col = (jx + 16 * (i0 + u)) * 4; w[u] = *(const GAS unsigned long long*)(x1_ + col); gg[u] = *(const GAS f32x4*)(g1_ + col); bb[u] = *(const GAS f32x4*)(b1_ + col); }
                  asm volatile("" : "+v"(w[0]), "+v"(w[1]), "+v"(w[2]), "+v"(w[3]), "+v"(w[4]), "+v"(w[5]), "+v"(w[6]), "+v"(w[7]),
                                    "+v"(gg[0]), "+v"(gg[1]), "+v"(gg[2]), "+v"(gg[3]), "+v"(gg[4]), "+v"(gg[5]), "+v"(gg[6]), "+v"(gg[7]),
                                    "+v"(bb[0]), "+v"(bb[1]), "+v"(bb[2]), "+v"(bb[3]), "+v"(bb[4]), "+v"(bb[5]), "+v"(bb[6]), "+v"(bb[7]));
#pragma unroll
                  for (int u = 0; u < 8; ++u) { const int i = i0 + u; const unsigned lo = (unsigned)w[u], hi = (unsigned)(w[u] >> 32);
                      const f32x4 y = {bflo(lo), bfhi(lo), bflo(hi), bfhi(hi)}; const f32x4 x = (y - mu1) * rstd1 * gg[u] + bb[u];
                      xr[2 * i] = (h2){(_Float16)x[0], (_Float16)x[1]}; xr[2 * i + 1] = (h2){(_Float16)x[2], (_Float16)x[3]}; } } }
            { LAS unsigned char* xs_ = F.lds + RING_OFF + 16384 + F.wave * 16384 + lane_ * 16;
#pragma unroll
              for (int i = 0; i < 16; ++i) { v4u w_; w_[0] = __builtin_bit_cast(unsigned, xr[4 * i]); w_[1] = __builtin_bit_cast(unsigned, xr[4 * i + 1]); w_[2] = __builtin_bit_cast(unsigned, xr[4 * i + 2]); w_[3] = __builtin_bit_cast(unsigned, xr[4 * i + 3]);
                  *(LAS v4u*)(xs_ + i * 1024) = w_; } }
            VM_WAIT(); LDS_WAIT();
            const unsigned char* pu_ = PU;
            sweep4<0>(pu_, xr, KL + q * 128, TC + q * 128, j);
        }
        { int tc = t, jc = j; asm volatile("" : "+v"(tc), "+v"(jc));
          const int* idx_ = IDX; const float* gate_ = GATE; const float* su_ = SU; const float* sv_ = SV;
          int id[8]; float gt[8], suv[8], svv[8];
#pragma unroll
          for (int r = 0; r < 8; ++r) { const int e = r * 16 + jc; id[r] = idx_[(size_t)tc * 128 + e]; gt[r] = gate_[(size_t)tc * 128 + e]; }
          asm volatile("" : "+v"(id[0]), "+v"(id[1]), "+v"(id[2]), "+v"(id[3]), "+v"(id[4]), "+v"(id[5]), "+v"(id[6]), "+v"(id[7]),
                            "+v"(gt[0]), "+v"(gt[1]), "+v"(gt[2]), "+v"(gt[3]), "+v"(gt[4]), "+v"(gt[5]), "+v"(gt[6]), "+v"(gt[7]));
#pragma unroll
          for (int r = 0; r < 8; ++r) { id[r] &= 16383; suv[r] = su_[id[r]]; svv[r] = sv_[id[r]]; }
          asm volatile("" : "+v"(suv[0]), "+v"(suv[1]), "+v"(suv[2]), "+v"(suv[3]), "+v"(suv[4]), "+v"(suv[5]), "+v"(suv[6]), "+v"(suv[7]),
                            "+v"(svv[0]), "+v"(svv[1]), "+v"(svv[2]), "+v"(svv[3]), "+v"(svv[4]), "+v"(svv[5]), "+v"(svv[6]), "+v"(svv[7]));
#pragma unroll
          for (int r = 0; r < 8; ++r) { const int e = r * 16 + jc;
              const float c = gt[r] * svv[r] * gelu_exact((float)TC[q * 128 + e] * suv[r]); TC[q * 128 + e] = (_Float16)c; } }
        LDS_WAIT();
        h2 acch[64];
#pragma unroll
        for (int i = 0; i < 64; ++i) acch[i] = (h2){(_Float16)0.f, (_Float16)0.f};
        { const unsigned char* pv_ = PV; sweep4<1>(pv_, acch, KL + q * 128, TC + q * 128, j); }
        {
            int tl = t, jl = j; asm volatile("" : "+v"(tl), "+v"(jl));
            const float* g = (const float*)ctx_ld(13) + (size_t)l * DM; const float* bta = (const float*)ctx_ld(14) + (size_t)l * DM;
            float* xout = last ? (float*)ctx_ld(15) : (float*)nullptr; bf16* xoutb = last ? (bf16*)nullptr : (bf16*)(PWS + WS_XB);
            f32x4 y[32]; float s = 0.f;
            { const LAS unsigned char* xs_ = F.lds + RING_OFF + 16384 + F.wave * 16384 + lane_ * 16;
#pragma unroll
              for (int i2 = 0; i2 < 16; ++i2) { const v4u w_ = *(const LAS v4u*)(xs_ + i2 * 1024);
#pragma unroll
                  for (int cc = 0; cc < 2; ++cc) { const int i = 2 * i2 + cc; const unsigned ua_ = w_[2 * cc], ub_ = w_[2 * cc + 1]; const h2 xa_ = __builtin_bit_cast(h2, ua_), xb_ = __builtin_bit_cast(h2, ub_);
                      y[i][0] = fmaf(DN_ALPHA, (float)xa_.x, (float)acch[2 * i].x); y[i][1] = fmaf(DN_ALPHA, (float)xa_.y, (float)acch[2 * i].y);
                      y[i][2] = fmaf(DN_ALPHA, (float)xb_.x, (float)acch[2 * i + 1].x); y[i][3] = fmaf(DN_ALPHA, (float)xb_.y, (float)acch[2 * i + 1].y);
                      s += (y[i][0] + y[i][1]) + (y[i][2] + y[i][3]); } } }
            const float mean = group_sum16(s) * (1.f / DM); float s2 = 0.f;
#pragma unroll
            for (int i = 0; i < 32; ++i) { y[i] = y[i] - mean; s2 += (y[i][0] * y[i][0] + y[i][1] * y[i][1]) + (y[i][2] * y[i][2] + y[i][3] * y[i][3]); }
            const float rstd = 1.f / sqrtf(group_sum16(s2) * (1.f / DM) + LN_EPS);
#pragma unroll
            for (int i0 = 0; i0 < 32; i0 += 8) {
                f32x4 gg[8], bb[8];
#pragma unroll
                for (int u = 0; u < 8; ++u) { const int col = (jl + 16 * (i0 + u)) * 4; gg[u] = *(const GAS f32x4*)(g + col); bb[u] = *(const GAS f32x4*)(bta + col); }
                asm volatile("" : "+v"(gg[0]), "+v"(gg[1]), "+v"(gg[2]), "+v"(gg[3]), "+v"(gg[4]), "+v"(gg[5]), "+v"(gg[6]), "+v"(gg[7]),
                                  "+v"(bb[0]), "+v"(bb[1]), "+v"(bb[2]), "+v"(bb[3]), "+v"(bb[4]), "+v"(bb[5]), "+v"(bb[6]), "+v"(bb[7]));
#pragma unroll
                for (int u = 0; u < 8; ++u) { const int col = (jl + 16 * (i0 + u)) * 4;
                    const f32x4 o = y[i0 + u] * rstd * gg[u] + bb[u];
                    if (xout) __builtin_nontemporal_store(o, (GAS f32x4*)(xout + (size_t)tl * DM + col));
                    if (xoutb) *(GAS unsigned long long*)(xoutb + (size_t)tl * DM + col) = (unsigned long long)pk2(o[0], o[1]) | ((unsigned long long)pk2(o[2], o[3]) << 32); } }
        }
    }
}
#undef PWS
#undef PU
#undef PV
#undef SU
#undef SV
#undef X1B_
#undef RSP_
#undef IDX
#undef GATE

constexpr int N_PHASES = 1 + 10 * DEPTH;
#ifndef MK_ONE_LAUNCH
#define MK_ONE_LAUNCH 0
#endif
struct Args { const float* in[15]; float* out; unsigned char* ws; int ph_lo, ph_hi; };
__global__ void __launch_bounds__(NWAVES * 64, 2) mk_fwd(Args args) {
    {
        LAS unsigned char* L = (LAS unsigned char*)lds_all; const int tid = threadIdx.x;
        for (int u = tid; u < (LDS_BYTES - LDSCTL_OFF) / 4; u += NWAVES * 64) ((LAS unsigned*)(L + LDSCTL_OFF))[u] = 0u;
        __syncthreads();
        if (tid < 17) { const unsigned long long v = tid < 15 ? (unsigned long long)args.in[tid] : (tid == 15 ? (unsigned long long)args.out : (unsigned long long)args.ws);
            ((LAS unsigned long long*)(L + CTX_OFF))[tid] = v; }
        __syncthreads();
        if (MK_ONE_LAUNCH) (void)xcd_barrier_post((unsigned*)((gu32*)(args.ws + WS_CTL) + CW_BAR), (volatile LAS unsigned*)(L + MISC_OFF) + 8);
    }
    const int wave_s__ = __builtin_amdgcn_readfirstlane((int)threadIdx.x >> 6);
    const int lo = args.ph_lo, hi = args.ph_hi;
#define IN(k) (lo <= (k) && (k) < hi)
#ifndef PHM
#define PHM 0xFFFF
#endif
#define PHM_ON(k) (((PHM) >> (k)) & 1)
#ifndef REPM
#define REPM 0
#endif
#define REPN(k) (1 + (((REPM) >> (k)) & 1))
#define SEAM(k) do { if (IN(k) && IN((k) + 1)) { XcdBarrier bar_; bar_.bar = (unsigned*)((gu32*)((unsigned char*)ctx_ld(16) + WS_CTL) + CW_BAR); bar_.x = xb_xcc_id(); bar_.lead = (opq_tid(wave_s__) == 0); \
        bar_.st = (volatile LAS unsigned*)((LAS unsigned char*)lds_all + MISC_OFF) + 8; xcd_barrier(bar_); } } while (0)

    if (PHM_ON(0) && IN(0)) { for (int rep_ = 0; rep_ < REPN(0); ++rep_) { Frame F; mk_frame(F, wave_s__); p0_prologue(F); } }
    SEAM(0);

    for (int l = 0; l < DEPTH; ++l) {
        const int pb = 1 + 10 * l;
        if (PHM_ON(1) && IN(pb + 0)) { for (int rep_ = 0; rep_ < REPN(1); ++rep_) { Frame F; mk_frame(F, wave_s__);
            pg8::Gemm g{(const bf16*)(F.ws + WS_XB), (const bf16*)(F.ws + WS_WIN) + (size_t)l * IN_COLS * DM, T, IN_COLS, DM, DM};
            pg8::StaticOrder S; S.init(T, IN_COLS, F.G, (int)blockIdx.x);
            pg8::EpiIn E{(bf16*)(F.ws + WS_QKV), (bf16*)(F.ws + WS_GATES), (const float*)(F.ws + WS_ROPE), (const float*)(F.ws + WS_ROPE) + SEQ * 16};
            pg8::gemm_phase<pg8::EpiIn, pg8::StaticOrder, true, true>(F.lds + RING_OFF, g, S, E, wave_s__);
        } }
        SEAM(pb + 0);
        if (PHM_ON(2) && IN(pb + 1)) { for (int rep_ = 0; rep_ < REPN(2); ++rep_) { Frame F; mk_frame(F, wave_s__); kmean_phase(F); } }
        SEAM(pb + 1);
        if (PHM_ON(3) && IN(pb + 2)) { for (int rep_ = 0; rep_ < REPN(3); ++rep_) { Frame F; mk_frame(F, wave_s__);
            gu32* head = F.ctl + CW_ATTQ + 64 * l + 32 * rep_;
            { const int ncu = F.G >= 4 * FP6_CUS ? FP6_CUS : (F.G + 3) / 4; if (F.vcu < ncu) convert_fp6_layer(F, l, F.vcu * NWAVES + F.wave, ncu * NWAVES); }
            if (F.G >= SPREAD_MIN_G) {
                if (F.vcu >= TR_CU0 && F.vcu < TR_CU0 + TR_CUS) transpose_range_deep(F, l * TI_LAYER + TI_IN, (l + 1) * TI_LAYER, (F.vcu - TR_CU0) * NWAVES + F.wave, TR_CUS * NWAVES);
                else if (l == 0 && F.vcu >= TW_CU0 && F.vcu < TW_CU0 + TW_CUS) transpose_range_deep(F, TI_LAYER, TI_LAYER + TI_IN, (F.vcu - TW_CU0) * NWAVES + F.wave, TW_CUS * NWAVES);
            }
            int L = att_fetch(F, head);
            if (L < 768) {
                att::Seam<bf16> Sm;
                att::BlockRef<bf16, bf16> cur = att_ref(F.ws, L);
                att::causal_swa_prime<bf16, bf16>(cur, SEQ, (char*)lds_all + RING_OFF, Sm, wave_s__);
                for (;;) {
                    const int Ln = att_fetch(F, head); const bool more = Ln < 768;
                    const att::BlockRef<bf16, bf16> nxt = more ? att_ref((unsigned char*)ctx_ld(16), Ln) : cur;
                    att::causal_swa_block<bf16, bf16>(cur, nxt, SEQ, SEQ, (char*)lds_all + RING_OFF, Sm, wave_s__);
                    if (!more) break;
                    cur = nxt;
                }
            }
        } }
        SEAM(pb + 2);
        if (PHM_ON(4) && IN(pb + 3)) { for (int rep_ = 0; rep_ < REPN(4); ++rep_) { Frame F; mk_frame(F, wave_s__); diffcomb_phase(F, l); } }
        SEAM(pb + 3);
        if (PHM_ON(5) && IN(pb + 4)) { for (int rep_ = 0; rep_ < REPN(5); ++rep_) { Frame F; mk_frame(F, wave_s__);
            pg8::PairOrder S; S.init(T, DM, F.G, (int)blockIdx.x, 1024 * 2);
            pg8::Gemm g{(const bf16*)(F.ws + WS_YMD), (const bf16*)(F.ws + WS_WBR) + (size_t)l * DM * DM, T, DM, 1024, DM};
            pg8::EpiBr E{(bf16*)(F.ws + WS_MB), (const bf16*)(F.ws + WS_GATES), (const bf16*)(F.ws + WS_GATES) + (size_t)T * DM};
            pg8::gemm_phase<pg8::EpiBr, pg8::PairOrder, true, true>(F.lds + RING_OFF, g, S, E, wave_s__);
        } }
        SEAM(pb + 4);
        if (PHM_ON(6) && IN(pb + 5)) { for (int rep_ = 0; rep_ < REPN(6); ++rep_) { Frame F; mk_frame(F, wave_s__);
            pg8::Gemm g{(const bf16*)(F.ws + WS_MB), (const bf16*)(F.ws + WS_WOUT) + (size_t)l * DM * DM, T, DM, DM, DM};
            pg8::StaticOrder S; S.init(T, DM, F.G, (int)blockIdx.x);
            pg8::EpiOut E{(l == 0) ? F.in[0] : (const float*)nullptr, (const bf16*)(F.ws + WS_XB), (bf16*)(F.ws + WS_X1B), (float*)(F.ws + WS_RSP) + (size_t)l * T * 64};
            pg8::gemm_phase<pg8::EpiOut, pg8::StaticOrder, true, true>(F.lds + RING_OFF, g, S, E, wave_s__);
        } }
        SEAM(pb + 5);
        if (PHM_ON(8) && IN(pb + 7)) { for (int rep_ = 0; rep_ < REPN(8); ++rep_) { Frame F; mk_frame(F, wave_s__);
            pg8::Gemm g{(const bf16*)(F.ws + WS_X1B), (const bf16*)(F.ws + WS_WQ) + (size_t)l * DM * DM, T, DM, DM, DM};
            pg8::StaticOrder S; S.init(T, DM, F.G, (int)blockIdx.x);
            LAS float* tab = (LAS float*)(F.lds + PEER_TC_OFF);
            { pg8::Unit u0; const bool has = S.next(0, u0);
              if (has) { const int i = F.tid & 255;
                if (F.tid < 256) { const float* rp = (const float*)(F.ws + WS_RSP) + ((size_t)l * T + (size_t)u0.pm * 256 + i) * 64; float s1 = 0.f, s2 = 0.f;
#pragma unroll 8
                    for (int q = 0; q < 32; ++q) { s1 += rp[2 * q]; s2 += rp[2 * q + 1]; }
                    const float mu = s1 * (1.f / DM); tab[i] = mu; tab[256 + i] = 1.f / sqrtf(s2 * (1.f / DM) - mu * mu + LN_EPS); }
                else { const float* p1 = (const float*)(F.ws + WS_C1P) + (size_t)l * 32 * DM + u0.pn * 256 + i; const float* p2 = (const float*)(F.ws + WS_C2P) + (size_t)l * 32 * DM + u0.pn * 256 + i; float a1 = 0.f, a2 = 0.f;
#pragma unroll 8
                    for (int q = 0; q < 32; ++q) { a1 += p1[(size_t)q * DM]; a2 += p2[(size_t)q * DM]; }
                    tab[512 + i] = a1; tab[768 + i] = a2; } }
              __syncthreads(); }
            pg8::EpiQ E{(bf16*)(F.ws + WS_QP), tab};
            pg8::gemm_phase<pg8::EpiQ, pg8::StaticOrder, true, true>(F.lds + RING_OFF, g, S, E, wave_s__);
        } }
        SEAM(pb + 7);
        if (PHM_ON(9) && IN(pb + 8)) { for (int rep_ = 0; rep_ < REPN(9); ++rep_) { Frame F; mk_frame(F, wave_s__); peer_topk_phase(F, l); } }
        SEAM(pb + 8);
        if (PHM_ON(10) && IN(pb + 9)) { for (int rep_ = 0; rep_ < REPN(10); ++rep_) { Frame F; mk_frame(F, wave_s__);
            peer_expert_phase(F, l, l == DEPTH - 1); } }
        SEAM(pb + 9);
    }
#undef IN
#undef SEAM
}

extern "C" void kernel_launch(void* const* d_in, const int* in_sizes, int n_in, void* d_out, int out_size, void* d_ws, size_t ws_size, hipStream_t stream) {
    static int grid = 0;
    if (grid == 0) {
        if (n_in != 15 || in_sizes[0] != T * DM || out_size != T * DM || ws_size < WS_END) {
            fprintf(stderr, "kernel_launch: expected 15 inputs, x/out of %d floats, >= %zu bytes of workspace; got n_in %d in0 %d out %d ws %zu\n", T * DM, (size_t)WS_END, n_in, n_in > 0 ? in_sizes[0] : -1, out_size, ws_size);
            grid = -1; return; }
        int dev = 0, cus = 0, per_cu = 0;
        if (hipGetDevice(&dev) != hipSuccess || hipDeviceGetAttribute(&cus, hipDeviceAttributeMultiprocessorCount, dev) != hipSuccess) { grid = -1; return; }
        if (hipFuncSetAttribute((const void*)mk_fwd, hipFuncAttributeMaxDynamicSharedMemorySize, LDS_BYTES) != hipSuccess) { fprintf(stderr, "kernel_launch: hipFuncSetAttribute failed\n"); grid = -1; return; }
        if (hipOccupancyMaxActiveBlocksPerMultiprocessor(&per_cu, (const void*)mk_fwd, NWAVES * 64, LDS_BYTES) != hipSuccess || per_cu < 1)
            fprintf(stderr, "kernel_launch: occupancy query reports %d workgroups per CU\n", per_cu);
        (void)hipGetLastError();
        grid = cus;
    }
    if (grid < 0) return;
    if (hipMemsetAsync((char*)d_ws + WS_CTL, 0, CTL_ZERO_BYTES, stream) != hipSuccess) { fprintf(stderr, "kernel_launch: memset failed\n"); return; }
    Args a{};
    for (int i = 0; i < 15; ++i) a.in[i] = (const float*)d_in[i];
    a.out = (float*)d_out; a.ws = (unsigned char*)d_ws;
    if (MK_ONE_LAUNCH) {
        a.ph_lo = 0; a.ph_hi = N_PHASES;
        hipLaunchKernelGGL(mk_fwd, dim3(grid), dim3(NWAVES * 64), LDS_BYTES, stream, a);
    } else {
        for (int p = 0; p < N_PHASES; ++p) { a.ph_lo = p; a.ph_hi = p + 1; hipLaunchKernelGGL(mk_fwd, dim3(grid), dim3(NWAVES * 64), LDS_BYTES, stream, a); }
    }
    const hipError_t le = hipPeekAtLastError();
    if (le != hipSuccess) fprintf(stderr, "kernel_launch: launch failed: %s\n", hipGetErrorName(le));
}
```
